# Optimizing an MI355X kernel written in HIP

```python
import jax, jax.numpy as jnp
from jax import lax
import numpy as np

D_MODEL = 1024
BATCH = 4
SEQ = 8192
DEPTH = 1

D_CONV = D_MODEL
CONV_GROUPS = 8
CONV_A_WIDTH = 3
D_RNN = D_MODEL
RNN_HEADS = 4
RNN_BLOCK = D_RNN // RNN_HEADS
CONV_B_WIDTH = 4
LRU_C = 8.0
D_FF = ((8 * D_MODEL + 3 * 256 - 1) // (3 * 256)) * 256
N_MOD = 6
EPS = 1e-6
IN_WIDTHS = (D_CONV, D_CONV, D_CONV, D_RNN, D_RNN, D_MODEL, D_MODEL)
IN_TOTAL = sum(IN_WIDTHS)
IN_SPLITS = tuple(int(v) for v in np.cumsum(IN_WIDTHS)[:-1])

kernel_name = "hybrid_conv_rglru_gated_merge_adaln"


def rmsnorm(x, g):
    xf = x.astype(jnp.float32)
    y = xf * lax.rsqrt(jnp.mean(xf * xf, axis=-1, keepdims=True) + EPS) * g.astype(jnp.float32)
    return y.astype(x.dtype)


def modulate(h, shift, scale):
    return h * (1.0 + scale[:, None, :]) + shift[:, None, :]


def causal_depthwise_conv(u, w):
    k, ch = w.shape
    return lax.conv_general_dilated(
        u, w[:, None, :].astype(u.dtype), window_strides=(1,), padding=[(k - 1, 0)],
        dimension_numbers=("NWC", "WIO", "NWC"), feature_group_count=ch)


def block_diag_linear(u, w, b):
    bs, s, d = u.shape
    uh = u.reshape(bs, s, RNN_HEADS, RNN_BLOCK)
    return jnp.einsum("bshi,hij->bshj", uh, w).reshape(bs, s, d) + b


def rg_lru(u, w_a, b_a, w_x, b_x, lam):
    r = jax.nn.sigmoid(block_diag_linear(u, w_a, b_a)).astype(jnp.float32)
    i = jax.nn.sigmoid(block_diag_linear(u, w_x, b_x))
    log_a = LRU_C * r * jax.nn.log_sigmoid(lam.astype(jnp.float32))
    a = jnp.exp(log_a)
    mult = jnp.sqrt(jnp.maximum(-jnp.expm1(2.0 * log_a), 0.0))
    mult = mult.at[:, 0].set(1.0)
    bx = mult * (i * u).astype(jnp.float32)

    def combine(left, right):
        a1, b1 = left
        a2, b2 = right
        return a1 * a2, a2 * b1 + b2

    _, h = lax.associative_scan(combine, (a, bx), axis=1)
    return h.astype(u.dtype)


def setup_inputs(seed: int = 0) -> dict:
    key = jax.random.key(seed)
    ks = jax.random.split(key, 20)
    f32 = jnp.float32
    nrm = lambda k, shape, s: jax.random.normal(k, shape, f32) * s
    a8 = jax.random.uniform(ks[11], (DEPTH, D_RNN), f32, 0.9, 0.999)
    base = a8 ** (1.0 / LRU_C)
    lru_lambda = jnp.log(base) - jnp.log1p(-base)
    return {
        "x": nrm(ks[0], (BATCH, SEQ, D_MODEL), 1.0),
        "c": nrm(ks[1], (BATCH, D_MODEL), 1.0),
        "w_ada": nrm(ks[2], (DEPTH, D_MODEL, N_MOD * D_MODEL), 0.5 * D_MODEL ** -0.5),
        "b_ada": nrm(ks[3], (DEPTH, N_MOD * D_MODEL), 0.01),
        "g_norm_mix": 1.0 + nrm(ks[4], (DEPTH, D_MODEL), 0.05),
        "w_in": nrm(ks[5], (DEPTH, D_MODEL, IN_TOTAL), D_MODEL ** -0.5),
        "conv_a_w": nrm(ks[6], (DEPTH, CONV_A_WIDTH, D_CONV), CONV_A_WIDTH ** -0.5),
        "conv_b_w": nrm(ks[7], (DEPTH, CONV_B_WIDTH, D_RNN), CONV_B_WIDTH ** -0.5),
        "conv_b_bias": nrm(ks[8], (DEPTH, D_RNN), 0.01),
        "w_rg_a": nrm(ks[9], (DEPTH, RNN_HEADS, RNN_BLOCK, RNN_BLOCK), RNN_BLOCK ** -0.5),
        "b_rg_a": nrm(ks[10], (DEPTH, D_RNN), 0.01),
        "w_rg_x": nrm(ks[12], (DEPTH, RNN_HEADS, RNN_BLOCK, RNN_BLOCK), RNN_BLOCK ** -0.5),
        "b_rg_x": nrm(ks[13], (DEPTH, D_RNN), 0.01),
        "lru_lambda": lru_lambda,
        "w_out": nrm(ks[14], (DEPTH, D_MODEL, D_MODEL), D_MODEL ** -0.5),
        "g_norm_ffn": 1.0 + nrm(ks[15], (DEPTH, D_MODEL), 0.05),
        "w_gate_up": nrm(ks[16], (DEPTH, D_MODEL, 2 * D_FF), D_MODEL ** -0.5),
        "w_down": nrm(ks[17], (DEPTH, D_FF, D_MODEL), D_FF ** -0.5),
        "g_norm_final": 1.0 + nrm(ks[18], (D_MODEL,), 0.05),
    }


def reference(x, c, w_ada, b_ada, g_norm_mix, w_in, conv_a_w, conv_b_w, conv_b_bias,
              w_rg_a, b_rg_a, w_rg_x, b_rg_x, lru_lambda, w_out, g_norm_ffn,
              w_gate_up, w_down, g_norm_final):
    c_act = jax.nn.silu(c)
    for l in range(DEPTH):
        mod = c_act @ w_ada[l] + b_ada[l]
        sh1, sc1, gt1, sh2, sc2, gt2 = jnp.split(mod, N_MOD, axis=-1)

        h = modulate(rmsnorm(x, g_norm_mix[l]), sh1, sc1)
        proj = h @ w_in[l]
        cb, cc, cx, rx, rg, ga, gb = jnp.split(proj, IN_SPLITS, axis=-1)
        y_a = cb * causal_depthwise_conv(cc * cx, conv_a_w[l])
        u = causal_depthwise_conv(rx, conv_b_w[l]) + conv_b_bias[l]
        y_b = rg_lru(u, w_rg_a[l], b_rg_a[l], w_rg_x[l], b_rg_x[l], lru_lambda[l]) * jax.nn.gelu(rg)
        merged = jax.nn.sigmoid(ga) * y_a + jax.nn.sigmoid(gb) * y_b
        x = x + gt1[:, None, :] * (merged @ w_out[l])

        h = modulate(rmsnorm(x, g_norm_ffn[l]), sh2, sc2)
        g_ff, u_ff = jnp.split(h @ w_gate_up[l], 2, axis=-1)
        x = x + gt2[:, None, :] * ((jax.nn.silu(g_ff) * u_ff) @ w_down[l])
    return rmsnorm(x, g_norm_final)
```

```cpp
#include <hip/hip_runtime.h>
#include <hip/hip_cooperative_groups.h>
#include <cstdio>
namespace cg = cooperative_groups;

#define LAS __attribute__((address_space(3)))
typedef unsigned short bf16_t;
typedef short bf16x8 __attribute__((ext_vector_type(8)));
typedef float f32x4 __attribute__((ext_vector_type(4)));
typedef float f32x2 __attribute__((ext_vector_type(2)));
typedef unsigned u32x4 __attribute__((ext_vector_type(4)));
typedef unsigned u32x2 __attribute__((ext_vector_type(2)));
typedef int i32x4 __attribute__((ext_vector_type(4)));

constexpr int M = 32768, D = 1024, SEQ = 8192, FF = 2816, NIN = 7168, NGU = 5632, NMOD = 6144;
constexpr float EPS = 1e-6f;
constexpr size_t MiB = (size_t)1 << 20;
constexpr size_t WS_MOD = 0, WS_LS8 = 128 * 1024, WS_APROD = 1 * MiB, WS_HEND = 3 * MiB, WS_CIN = 5 * MiB;
constexpr size_t WS_WIN = 8 * MiB, WS_WGU = 22 * MiB, WS_WDN = 33 * MiB, WS_WOUT = 39 * MiB, WS_WRG = 41 * MiB;
constexpr size_t WS_H = 48 * MiB, WS_SA = 112 * MiB, WS_P = 176 * MiB, WS_G2 = 240 * MiB, WS_RX = 304 * MiB, WS_BX = 368 * MiB, WS_END = 496 * MiB;
constexpr size_t WS_ACT = 112 * MiB;
constexpr int LDS_XCH = 131072 + 16;
constexpr int LDS_BYTES = 131072 + 16 + 1024;
constexpr size_t WS_BAR = 256 * 1024;
constexpr size_t WS_RSS1 = 272 * 1024, WS_RSS2 = 400 * 1024;
constexpr size_t WS_CNT1 = 528 * 1024, WS_CNT2 = 592 * 1024;
constexpr size_t WS_CMAXIN = 656 * 1024, WS_CMAXGU = 688 * 1024;
constexpr size_t WS_RMX = 720 * 1024, WS_FLAG = 848 * 1024, WS_CTL_END = 852 * 1024;
constexpr size_t WS_TOT = 1 * MiB;
constexpr size_t WS_SA1 = 5 * MiB, WS_SA2 = WS_SA1 + 128 * 1024, WS_SBIN = WS_SA2 + 128 * 1024, WS_SBGU = WS_SBIN + 32 * 1024, WS_SHMAX = WS_SBGU + 32 * 1024;
#ifndef P2_I8
#define P2_I8 2
#endif
#ifndef P10_I8
#define P10_I8 1
#endif
#ifndef FIX_IN_P4
#define FIX_IN_P4 1
#endif
#ifndef SCAN_FUSED
#define SCAN_FUSED 1
#endif
#ifndef CONV4_FUSED
#define CONV4_FUSED 1
#endif
#ifndef CONV3_FUSED
#define CONV3_FUSED 1
#endif
#ifndef KREP2
#define KREP2 1
#endif
#ifndef EREPX
#define EREPX 1
#endif
#ifndef NPASS
#define NPASS 1
#endif
#ifndef REP1
#define REP1 1
#endif
#ifndef REP3
#define REP3 1
#endif
#ifndef REP7
#define REP7 1
#endif
#ifndef REP0
#define REP0 1
#endif
#ifndef REP2
#define REP2 1
#endif
#ifndef REP4
#define REP4 1
#endif
#ifndef REP8
#define REP8 1
#endif
#ifndef REP10
#define REP10 1
#endif
#ifndef REP11
#define REP11 1
#endif

namespace pg8 {
constexpr int BM = 256, BK = 64, HALF = 128, HTB = HALF * BK * 2, STAGE_BYTES = 8 * HTB, NXCD = 8, WGM = 4;
__host__ __device__ __forceinline__ int lds_byte(int r, int c) { const int st = (r >> 4) * 2 + (c >> 5), rr = r & 15, cc = c & 31, ob = rr * 64 + cc * 2; return st * 1024 + (ob ^ (((ob >> 9) & 1) << 5)); }
__host__ __device__ __forceinline__ void stage_rc(int b, int& R, int& C) { const int st = b / 1024, sb = b % 1024, swz = sb ^ (((sb >> 9) & 1) << 5); R = (st >> 1) * 16 + swz / 64; C = (st & 1) * 32 + (swz % 64) / 2; }
struct Unit { int pm, pn; };
struct Gemm { const bf16_t* A; const bf16_t* Bt; int M, N, K, lda, ldb, a_pn_shift; };
struct StaticOrder {
    int nM, nN, nwg, G, c, chain;
    __host__ __device__ void init(int M_, int N_, int G_, int c_) { nM = M_ / BM; nN = N_ / BM; nwg = nM * nN; G = G_; c = c_; chain = 0; }
    __host__ __device__ bool next(int i, Unit& u) const {
        if (chain) { if (i >= 4) return false; const int x = c & 7, j = c >> 3; u.pm = 32 * (x >> 1) + 8 * i + (x & 1) * 4 + (j >> 3); u.pn = j & 7; return true; }
        const long L = (long)i * G + c; if (L >= nwg) return false;
        int wgid = (int)L; { const int q = nwg / NXCD, r = nwg % NXCD, xcd = wgid % NXCD, off = wgid / NXCD; wgid = (xcd < r ? xcd * (q + 1) : r * (q + 1) + (xcd - r) * q) + off; }
        const int nig = WGM * nN, gid = wgid / nig, fm = gid * WGM, gsz = (nM - fm) < WGM ? (nM - fm) : WGM;
        u.pm = fm + ((wgid % nig) % gsz); u.pn = (wgid % nig) / gsz; return true;
    }
};
__device__ __forceinline__ unsigned cvt_pk_bf16(float lo, float hi) { unsigned r; asm volatile("v_cvt_pk_bf16_f32 %0, %1, %2" : "=v"(r) : "v"(lo), "v"(hi)); return r; }

template <class Epi, bool APERM = false, int KREP = 1, int EREP = 1>
__device__ __forceinline__ void gemm_phase(LAS unsigned char* lds, const Gemm g, const StaticOrder& S, const Epi& E) {
    int tid = threadIdx.x; asm volatile("" : "+v"(tid));
    const int wid = __builtin_amdgcn_readfirstlane(tid >> 6), lane = tid & 63, wr = wid >> 2, wc = wid & 3, fr = lane & 15, fq = lane >> 4;
    int K = g.K; asm volatile("" : "+s"(K)); const int nt = K / BK;
    unsigned voffA[2], voffB[2];
#pragma unroll
    for (int i = 0; i < 2; ++i) { int R, C; stage_rc(tid * 16 + i * 8192, R, C); const int Ra = APERM ? (8 * ((R & 15) + 16 * (R >> 6)) + ((R >> 4) & 3)) : R; voffA[i] = (unsigned)(Ra * g.lda + C) * 2u; voffB[i] = (unsigned)(R * g.ldb + C) * 2u; }
    const size_t kstep = (size_t)(BK * 2);
    const size_t hstepA = (size_t)(APERM ? 4 : HALF) * g.lda * 2, hstepB = (size_t)HALF * g.ldb * 2;
    const size_t tstepA = (size_t)BM * g.lda * 2, tstepB = 2 * hstepB;
    const unsigned ldsw = (unsigned)wid * 1024u;
    const int aoff = lds_byte(wr * 64 + fr, fq * 8), boff = lds_byte(wc * 32 + fr, fq * 8);
#define PG8_SA(b, h) (((b) * 2 + (h)) * HTB)
#define PG8_SB(b, h) ((4 + (b) * 2 + (h)) * HTB)
#define PG8_STAGE(bufoff, gbase, voff) do { _Pragma("unroll") for (int _i = 0; _i < 2; ++_i) \
        __builtin_amdgcn_global_load_lds((const unsigned*)((const char*)(gbase) + (voff)[_i]), (LAS unsigned*)(lds + (bufoff) + ldsw + _i * 8192), 16, 0, 0); } while (0)
#define PG8_LDA(dst, b, h) do { _Pragma("unroll") for (int m = 0; m < 4; ++m) _Pragma("unroll") for (int k = 0; k < 2; ++k) dst[m][k] = *(const LAS bf16x8*)(lds + PG8_SA(b, h) + aoff + m * 2048 + k * 1024); } while (0)
#define PG8_LDB(dst, b, h) do { _Pragma("unroll") for (int n = 0; n < 2; ++n) _Pragma("unroll") for (int k = 0; k < 2; ++k) dst[n][k] = *(const LAS bf16x8*)(lds + PG8_SB(b, h) + boff + n * 2048 + k * 1024); } while (0)
#define PG8_MMA(ai, bj, At, Bt) do { __builtin_amdgcn_s_setprio(1); _Pragma("unroll") for (int m = 0; m < 4; ++m) _Pragma("unroll") for (int n = 0; n < 2; ++n) _Pragma("unroll") for (int k = 0; k < 2; ++k) \
        acc[ai][bj][m][n] = __builtin_amdgcn_mfma_f32_16x16x32_bf16(Bt[n][k], At[m][k], acc[ai][bj][m][n], 0, 0, 0); __builtin_amdgcn_s_setprio(0); } while (0)
#define PG8_WAIT_V(n) asm volatile("s_waitcnt vmcnt(" #n ")" ::: "memory")
#define PG8_WAIT_L(n) asm volatile("s_waitcnt lgkmcnt(" #n ")" ::: "memory")
#define PG8_BAR __builtin_amdgcn_s_barrier()
#define PG8_SCHED __builtin_amdgcn_sched_barrier(0)
#define PG8_APTR(u) ((const char*)g.A + (size_t)(u).pm * tstepA + (g.a_pn_shift >= 0 ? (size_t)((u).pn >> g.a_pn_shift) * (size_t)K * 2 : (size_t)0))
#define PG8_BPTR(u) ((const char*)g.Bt + (size_t)(u).pn * tstepB)
    Unit cur, nxt; int ui = 0;
    if (!S.next(0, cur)) return;
    f32x4 acc[2][2][4][2];
#pragma unroll
    for (int a = 0; a < 2; ++a)
#pragma unroll
        for (int b = 0; b < 2; ++b)
#pragma unroll
            for (int m = 0; m < 4; ++m)
#pragma unroll
                for (int n = 0; n < 2; ++n) acc[a][b][m][n] = (f32x4){0.f, 0.f, 0.f, 0.f};
    bf16x8 At[4][2], B0[2][2], B1[2][2];
    const char* cA = PG8_APTR(cur); const char* cB = PG8_BPTR(cur);
    PG8_STAGE(PG8_SB(0, 0), cB, voffB); PG8_STAGE(PG8_SA(0, 0), cA, voffA); PG8_STAGE(PG8_SB(0, 1), cB + hstepB, voffB); PG8_STAGE(PG8_SA(0, 1), cA + hstepA, voffA);
    if (wr == 1) PG8_BAR;
    PG8_WAIT_V(4); PG8_BAR;
    PG8_STAGE(PG8_SB(1, 0), cB + kstep, voffB); PG8_STAGE(PG8_SA(1, 0), cA + kstep, voffA); PG8_STAGE(PG8_SB(1, 1), cB + hstepB + kstep, voffB);
    PG8_WAIT_V(6); PG8_BAR;
    for (;;) {
        const bool has_next = S.next((ui + 1) / KREP, nxt);
        const char* nA = has_next ? PG8_APTR(nxt) : cA; const char* nB = has_next ? PG8_BPTR(nxt) : cB;
#pragma unroll 1
        for (int t = 0; t < nt; t += 2) {
            const bool last = (t == nt - 2);
            const char* a1 = cA + (size_t)(t + 1) * kstep;
            const char* a2 = last ? nA : cA + (size_t)(t + 2) * kstep; const char* b2 = last ? nB : cB + (size_t)(t + 2) * kstep;
            const char* a3 = a2 + kstep; const char* b3 = b2 + kstep;
            PG8_LDB(B0, 0, 0); PG8_SCHED; PG8_LDA(At, 0, 0); PG8_STAGE(PG8_SA(1, 1), a1 + hstepA, voffA);
            PG8_WAIT_L(8); PG8_BAR; PG8_WAIT_L(0); PG8_MMA(0, 0, At, B0); PG8_BAR; PG8_SCHED;
            PG8_LDB(B1, 0, 1); PG8_STAGE(PG8_SB(0, 0), b2, voffB);
            PG8_BAR; PG8_WAIT_L(0); PG8_MMA(0, 1, At, B1); PG8_BAR;
            PG8_LDA(At, 0, 1); PG8_STAGE(PG8_SA(0, 0), a2, voffA);
            PG8_BAR; PG8_WAIT_L(0); PG8_MMA(1, 0, At, B0); PG8_BAR; PG8_SCHED;
            PG8_STAGE(PG8_SB(0, 1), b2 + hstepB, voffB);
            PG8_WAIT_V(6); PG8_BAR; PG8_MMA(1, 1, At, B1); PG8_BAR;
            PG8_LDB(B0, 1, 0); PG8_SCHED; PG8_LDA(At, 1, 0); PG8_STAGE(PG8_SA(0, 1), a2 + hstepA, voffA);
            PG8_WAIT_L(8); PG8_BAR; PG8_WAIT_L(0); PG8_MMA(0, 0, At, B0); PG8_BAR; PG8_SCHED;
            PG8_LDB(B1, 1, 1); PG8_STAGE(PG8_SB(1, 0), b3, voffB);
            PG8_BAR; PG8_WAIT_L(0); PG8_MMA(0, 1, At, B1); PG8_BAR;
            PG8_LDA(At, 1, 1); PG8_STAGE(PG8_SA(1, 0), a3, voffA);
            PG8_BAR; PG8_WAIT_L(0); PG8_MMA(1, 0, At, B0); PG8_BAR; PG8_SCHED;
            PG8_STAGE(PG8_SB(1, 1), b3 + hstepB, voffB);
            PG8_WAIT_V(6); PG8_BAR; PG8_MMA(1, 1, At, B1); PG8_BAR;
        }
        if ((ui % KREP) == KREP - 1) {
        if (wr == 0) PG8_BAR;
        E(acc, cur, wr, wc, fr, fq);
        if (EREP > 1) {
_Pragma("unroll") for (int a = 0; a < 2; ++a) _Pragma("unroll") for (int b = 0; b < 2; ++b) _Pragma("unroll") for (int m = 0; m < 4; ++m) _Pragma("unroll") for (int n = 0; n < 2; ++n) asm volatile("" : "+v"(acc[a][b][m][n]));
            E(acc, cur, wr, wc, fr, fq); }
        if (wr == 1) PG8_BAR;
        }
        if (!has_next) break;
#pragma unroll
        for (int a = 0; a < 2; ++a)
#pragma unroll
            for (int b = 0; b < 2; ++b)
#pragma unroll
                for (int m = 0; m < 4; ++m)
#pragma unroll
                    for (int n = 0; n < 2; ++n) acc[a][b][m][n] = (f32x4){0.f, 0.f, 0.f, 0.f};
        cur = nxt; cA = nA; cB = nB; ++ui;
    }
    PG8_WAIT_V(0);
    if (wr == 0) PG8_BAR;
    PG8_BAR;
#undef PG8_SA
#undef PG8_SB
#undef PG8_STAGE
#undef PG8_LDA
#undef PG8_LDB
#undef PG8_MMA
#undef PG8_WAIT_V
#undef PG8_WAIT_L
#undef PG8_BAR
#undef PG8_SCHED
#undef PG8_APTR
#undef PG8_BPTR
}

struct GemmI8 { const signed char* A; const signed char* Bt; int M, N, K, lda, ldb; };
template <class Epi, bool APERM = false>
__device__ __forceinline__ void gemm_phase_i8(LAS unsigned char* lds, const GemmI8 g, const StaticOrder& S, const Epi& E) {
    int tid = threadIdx.x; asm volatile("" : "+v"(tid));
    const int wid = __builtin_amdgcn_readfirstlane(tid >> 6), lane = tid & 63, wr = wid >> 2, wc = wid & 3, fr = lane & 15, fq = lane >> 4;
    int K = g.K; asm volatile("" : "+s"(K)); const int nt = K / 128;
    unsigned voffA[2], voffB[2];
#pragma unroll
    for (int i = 0; i < 2; ++i) { int R, C; stage_rc(tid * 16 + i * 8192, R, C); const int Ra = APERM ? (8 * ((R & 15) + 16 * (R >> 6)) + ((R >> 4) & 3)) : R; voffA[i] = (unsigned)(Ra * g.lda + 2 * C); voffB[i] = (unsigned)(R * g.ldb + 2 * C); }
    const size_t kstep = (size_t)(BK * 2);
    const size_t hstepA = (size_t)(APERM ? 4 : HALF) * g.lda, hstepB = (size_t)HALF * g.ldb;
    const size_t tstepA = (size_t)BM * g.lda, tstepB = 2 * hstepB;
    const unsigned ldsw = (unsigned)wid * 1024u;
    const int aoff = lds_byte(wr * 64 + fr, fq * 8), boff = lds_byte(wc * 32 + fr, fq * 8);
#define PG8_SA(b, h) (((b) * 2 + (h)) * HTB)
#define PG8_SB(b, h) ((4 + (b) * 2 + (h)) * HTB)
#define PG8_STAGE(bufoff, gbase, voff) do { _Pragma("unroll") for (int _i = 0; _i < 2; ++_i) \
        __builtin_amdgcn_global_load_lds((const unsigned*)((const char*)(gbase) + (voff)[_i]), (LAS unsigned*)(lds + (bufoff) + ldsw + _i * 8192), 16, 0, 0); } while (0)
#define PG8_LDA(dst, b, h) do { _Pragma("unroll") for (int m = 0; m < 4; ++m) _Pragma("unroll") for (int k = 0; k < 2; ++k) dst[m][k] = *(const LAS bf16x8*)(lds + PG8_SA(b, h) + aoff + m * 2048 + k * 1024); } while (0)
#define PG8_LDB(dst, b, h) do { _Pragma("unroll") for (int n = 0; n < 2; ++n) _Pragma("unroll") for (int k = 0; k < 2; ++k) dst[n][k] = *(const LAS bf16x8*)(lds + PG8_SB(b, h) + boff + n * 2048 + k * 1024); } while (0)
#define PG8_MMA(ai, bj, At, Bt) do { __builtin_amdgcn_s_setprio(1); _Pragma("unroll") for (int m = 0; m < 4; ++m) _Pragma("unroll") for (int n = 0; n < 2; ++n) _Pragma("unroll") for (int k = 0; k < 2; ++k) \
        acc[ai][bj][m][n] = __builtin_amdgcn_mfma_i32_16x16x64_i8(__builtin_bit_cast(i32x4, Bt[n][k]), __builtin_bit_cast(i32x4, At[m][k]), acc[ai][bj][m][n], 0, 0, 0); __builtin_amdgcn_s_setprio(0); } while (0)
#define PG8_WAIT_V(n) asm volatile("s_waitcnt vmcnt(" #n ")" ::: "memory")
#define PG8_WAIT_L(n) asm volatile("s_waitcnt lgkmcnt(" #n ")" ::: "memory")
#define PG8_BAR __builtin_amdgcn_s_barrier()
#define PG8_SCHED __builtin_amdgcn_sched_barrier(0)
#define PG8_APTR(u) ((const char*)g.A + (size_t)(u).pm * tstepA)
#define PG8_BPTR(u) ((const char*)g.Bt + (size_t)(u).pn * tstepB)
    Unit cur, nxt; int ui = 0;
    if (!S.next(0, cur)) return;
    i32x4 acc[2][2][4][2];
#pragma unroll
    for (int a = 0; a < 2; ++a)
#pragma unroll
        for (int b = 0; b < 2; ++b)
#pragma unroll
            for (int m = 0; m < 4; ++m)
#pragma unroll
                for (int n = 0; n < 2; ++n) acc[a][b][m][n] = (i32x4){0, 0, 0, 0};
    bf16x8 At[4][2], B0[2][2], B1[2][2];
    const char* cA = PG8_APTR(cur); const char* cB = PG8_BPTR(cur);
    PG8_STAGE(PG8_SB(0, 0), cB, voffB); PG8_STAGE(PG8_SA(0, 0), cA, voffA); PG8_STAGE(PG8_SB(0, 1), cB + hstepB, voffB); PG8_STAGE(PG8_SA(0, 1), cA + hstepA, voffA);
    if (wr == 1) PG8_BAR;
    PG8_WAIT_V(4); PG8_BAR;
    PG8_STAGE(PG8_SB(1, 0), cB + kstep, voffB); PG8_STAGE(PG8_SA(1, 0), cA + kstep, voffA); PG8_STAGE(PG8_SB(1, 1), cB + hstepB + kstep, voffB);
    PG8_WAIT_V(6); PG8_BAR;
    for (;;) {
        const bool has_next = S.next(ui + 1, nxt);
        const char* nA = has_next ? PG8_APTR(nxt) : cA; const char* nB = has_next ? PG8_BPTR(nxt) : cB;
#pragma unroll 1
        for (int t = 0; t < nt; t += 2) {
            const bool last = (t == nt - 2);
            const char* a1 = cA + (size_t)(t + 1) * kstep;
            const char* a2 = last ? nA : cA + (size_t)(t + 2) * kstep; const char* b2 = last ? nB : cB + (size_t)(t + 2) * kstep;
            const char* a3 = a2 + kstep; const char* b3 = b2 + kstep;
            PG8_LDB(B0, 0, 0); PG8_SCHED; PG8_LDA(At, 0, 0); PG8_STAGE(PG8_SA(1, 1), a1 + hstepA, voffA);
            PG8_WAIT_L(8); PG8_BAR; PG8_WAIT_L(0); PG8_MMA(0, 0, At, B0); PG8_BAR; PG8_SCHED;
            PG8_LDB(B1, 0, 1); PG8_STAGE(PG8_SB(0, 0), b2, voffB);
            PG8_BAR; PG8_WAIT_L(0); PG8_MMA(0, 1, At, B1); PG8_BAR;
            PG8_LDA(At, 0, 1); PG8_STAGE(PG8_SA(0, 0), a2, voffA);
            PG8_BAR; PG8_WAIT_L(0); PG8_MMA(1, 0, At, B0); PG8_BAR; PG8_SCHED;
            PG8_STAGE(PG8_SB(0, 1), b2 + hstepB, voffB);
            PG8_WAIT_V(6); PG8_BAR; PG8_MMA(1, 1, At, B1); PG8_BAR;
            PG8_LDB(B0, 1, 0); PG8_SCHED; PG8_LDA(At, 1, 0); PG8_STAGE(PG8_SA(0, 1), a2 + hstepA, voffA);
            PG8_WAIT_L(8); PG8_BAR; PG8_WAIT_L(0); PG8_MMA(0, 0, At, B0); PG8_BAR; PG8_SCHED;
            PG8_LDB(B1, 1, 1); PG8_STAGE(PG8_SB(1, 0), b3, voffB);
            PG8_BAR; PG8_WAIT_L(0); PG8_MMA(0, 1, At, B1); PG8_BAR;
            PG8_LDA(At, 1, 1); PG8_STAGE(PG8_SA(1, 0), a3, voffA);
            PG8_BAR; PG8_WAIT_L(0); PG8_MMA(1, 0, At, B0); PG8_BAR; PG8_SCHED;
            PG8_STAGE(PG8_SB(1, 1), b3 + hstepB, voffB);
            PG8_WAIT_V(6); PG8_BAR; PG8_MMA(1, 1, At, B1); PG8_BAR;
        }
        if (wr == 0) PG8_BAR;
        E(acc, cur, wr, wc, fr, fq);
        if (wr == 1) PG8_BAR;
        if (!has_next) break;
#pragma unroll
        for (int a = 0; a < 2; ++a)
#pragma unroll
            for (int b = 0; b < 2; ++b)
#pragma unroll
                for (int m = 0; m < 4; ++m)
#pragma unroll
                    for (int n = 0; n < 2; ++n) acc[a][b][m][n] = (i32x4){0, 0, 0, 0};
        cur = nxt; cA = nA; cB = nB; ++ui;
    }
    PG8_WAIT_V(0);
    if (wr == 0) PG8_BAR;
    PG8_BAR;
#undef PG8_SA
#undef PG8_SB
#undef PG8_STAGE
#undef PG8_LDA
#undef PG8_LDB
#undef PG8_MMA
#undef PG8_WAIT_V
#undef PG8_WAIT_L
#undef PG8_BAR
#undef PG8_SCHED
#undef PG8_APTR
#undef PG8_BPTR
}
}
using pg8::cvt_pk_bf16;


#define XB_TMO      128
#define XB_XCNT(j)  (256  + 64 * (j))
#define XB_XSUB(j)  (1280 + 64 * (j))
#define XB_XGEN(j)  (2304 + 64 * (j))
#define XB_TOP      3328
#define XB_TOPGEN   3392
#define XCD_BAR_WORDS 3456
#define XB_SPIN_CAP (1u << 18)
__device__ __forceinline__ unsigned xb_ld(unsigned* p)              { return __hip_atomic_load(p, __ATOMIC_RELAXED, __HIP_MEMORY_SCOPE_AGENT); }
__device__ __forceinline__ unsigned xb_add(unsigned* p, unsigned v) { return __hip_atomic_fetch_add(p, v, __ATOMIC_RELAXED, __HIP_MEMORY_SCOPE_AGENT); }
__device__ __forceinline__ unsigned xb_xcc_id() { return (unsigned)__builtin_amdgcn_s_getreg((3 << 11) | 20) & 0xFu; }
#define XB_SPIN(cond, bar) do { unsigned _sp = 0; while (cond) { __builtin_amdgcn_s_sleep(1); \
    if ((++_sp & 255u) == 0u) { if (xb_ld(&(bar)[XB_TMO])) break; if (_sp > XB_SPIN_CAP) { atomicAdd(&(bar)[XB_TMO], 1u); break; } } } } while (0)
struct XcdBarrier { unsigned* bar; unsigned x; volatile LAS unsigned* st; };
__device__ __forceinline__ void xcd_barrier_post(unsigned* bar) { if (threadIdx.x == 0) (void)xb_add(&bar[XB_XCNT(xb_xcc_id())], 1u); }
__device__ __forceinline__ void xcd_barrier_complete(unsigned* bar, unsigned x, unsigned& nloc, unsigned& nx) {
    const unsigned G = gridDim.x * gridDim.y * gridDim.z;
    unsigned sum, cnt, mine, sp = 0u;
    for (;;) {
        sum = 0u; cnt = 0u; mine = 0u;
#pragma unroll
        for (unsigned j = 0; j < 16; ++j) { const unsigned c = xb_ld(&bar[XB_XCNT(j)]); sum += c; cnt += (c > 0u) ? 1u : 0u; mine = (j == x) ? c : mine; }
        if (sum == G) break;
        __builtin_amdgcn_s_sleep(1);
        if ((++sp & 255u) == 0u) { if (xb_ld(&bar[XB_TMO])) break; if (sp > XB_SPIN_CAP) { atomicAdd(&bar[XB_TMO], 1u); break; } }
    }
    nloc = mine > 0u ? mine : 1u; nx = cnt > 0u ? cnt : 1u;
}
__device__ __forceinline__ void xcd_barrier(const XcdBarrier& b) {
    asm volatile("s_waitcnt vmcnt(0)" ::: "memory");
    __syncthreads();
    if (threadIdx.x == 0) {
        unsigned* bar = b.bar;
        __builtin_amdgcn_s_waitcnt(0);
        unsigned nloc = b.st[0], nx = b.st[1];
        if (nloc == 0u) { xcd_barrier_complete(bar, b.x, nloc, nx); b.st[0] = nloc; b.st[1] = nx; }
        const unsigned old = xb_add(&bar[XB_XSUB(b.x)], 1u);
        const unsigned gen = old / nloc;
        if (old + 1u == (gen + 1u) * nloc) {
            __builtin_amdgcn_fence(__ATOMIC_RELEASE, "agent");
            asm volatile("s_waitcnt vmcnt(0)" ::: "memory");
            const unsigned og = xb_add(&bar[XB_TOP], 1u);
            const unsigned tg = og / nx;
            if (og + 1u == (tg + 1u) * nx) xb_add(&bar[XB_TOPGEN], 1u);
            else XB_SPIN(xb_ld(&bar[XB_TOPGEN]) == tg, bar);
            __builtin_amdgcn_fence(__ATOMIC_ACQUIRE, "agent");
            xb_add(&bar[XB_XGEN(b.x)], 1u);
            asm volatile("s_waitcnt vmcnt(0)" ::: "memory");
        } else {
            XB_SPIN(xb_ld(&bar[XB_XGEN(b.x)]) == gen, bar);
            __builtin_amdgcn_fence(__ATOMIC_ACQUIRE, "agent");
            asm volatile("s_waitcnt vmcnt(0)" ::: "memory");
        }
    }
    __syncthreads();
}

__device__ __forceinline__ float sigm(float x) { return __builtin_amdgcn_rcpf(1.0f + __expf(-x)); }
__device__ __forceinline__ float gelu_tanh(float x) { return x * sigm(1.5957691216057308f * (x + 0.044715f * x * x * x)); }
__device__ __forceinline__ float sigm_gelu(float gb, float x) {
    const float t = x * x, u = __builtin_fmaf(t, -1.5957691216057308f * 1.4426950408889634f * 0.044715f, -1.5957691216057308f * 1.4426950408889634f);
    const float e1 = __builtin_amdgcn_exp2f(x * u), e2 = __builtin_amdgcn_exp2f(gb * -1.4426950408889634f);
    const float d = __builtin_fmaf(e1, e2, e1 + e2) + 1.0f;
    return x * __builtin_amdgcn_rcpf(d);
}
__device__ __forceinline__ float bf_lo(unsigned u) { return __uint_as_float(u << 16); }
__device__ __forceinline__ float bf_hi(unsigned u) { return __uint_as_float(u & 0xffff0000u); }
__device__ __forceinline__ float wave_sum(float v) {
#pragma unroll
    for (int o = 32; o >= 1; o >>= 1) v += __shfl_xor(v, o);
    return v;
}
__device__ __forceinline__ int slot8(int cit) { return (cit & ~31) | (((cit >> 2) & 1) << 4) | (((cit >> 3) & 3) << 2) | (cit & 3); }

struct Epi1 {
    bf16_t *sA, *p, *g2, *rx;
    __device__ __forceinline__ void operator()(const f32x4 (&acc)[2][2][4][2], const pg8::Unit& u, int wr, int wc, int fr, int fq) const {
        const int row0 = u.pm * 256 + wr * 64 + fr;
        if (u.pn < 16) {
            const int ch = u.pn * 64 + wc * 16 + fq * 4;
#pragma unroll
            for (int ai = 0; ai < 2; ++ai)
#pragma unroll
                for (int m = 0; m < 4; ++m) {
                    const size_t off = (size_t)(row0 + ai * 128 + m * 16) * D + ch;
                    const f32x4 cb = acc[ai][0][m][0], cc = acc[ai][0][m][1], cx = acc[ai][1][m][0], ga = acc[ai][1][m][1];
                    float s[4], q[4];
#pragma unroll
                    for (int j = 0; j < 4; ++j) { s[j] = sigm(ga[j]) * cb[j]; q[j] = cc[j] * cx[j]; }
                    u32x2 w0, w1; w0.x = cvt_pk_bf16(s[0], s[1]); w0.y = cvt_pk_bf16(s[2], s[3]); w1.x = cvt_pk_bf16(q[0], q[1]); w1.y = cvt_pk_bf16(q[2], q[3]);
                    *(u32x2*)(sA + off) = w0; *(u32x2*)(p + off) = w1;
                }
        } else if (u.pn < 24) {
            const int ch = (u.pn - 16) * 128 + wc * 32 + fq * 8;
#pragma unroll
            for (int ai = 0; ai < 2; ++ai)
#pragma unroll
                for (int m = 0; m < 4; ++m) {
                    const size_t off = (size_t)(row0 + ai * 128 + m * 16) * D + ch;
                    float v[8];
#pragma unroll
                    for (int n = 0; n < 2; ++n)
#pragma unroll
                        for (int j = 0; j < 4; ++j) v[4 * n + j] = sigm_gelu(acc[ai][1][m][n][j], acc[ai][0][m][n][j]);
                    u32x4 w; w.x = cvt_pk_bf16(v[0], v[1]); w.y = cvt_pk_bf16(v[2], v[3]); w.z = cvt_pk_bf16(v[4], v[5]); w.w = cvt_pk_bf16(v[6], v[7]);
                    *(u32x4*)(g2 + off) = w;
                }
        } else {
#pragma unroll
            for (int ai = 0; ai < 2; ++ai)
#pragma unroll
                for (int m = 0; m < 4; ++m)
#pragma unroll
                    for (int bj = 0; bj < 2; ++bj) {
                        const size_t off = (size_t)(row0 + ai * 128 + m * 16) * D + (u.pn - 24) * 256 + bj * 128 + wc * 32 + fq * 8;
                        const f32x4 v0 = acc[ai][bj][m][0], v1 = acc[ai][bj][m][1];
                        u32x4 w; w.x = cvt_pk_bf16(v0[0], v0[1]); w.y = cvt_pk_bf16(v0[2], v0[3]); w.z = cvt_pk_bf16(v1[0], v1[1]); w.w = cvt_pk_bf16(v1[2], v1[3]);
                        *(u32x4*)(rx + off) = w;
                    }
        }
    }
};

template <class Inner> struct EpiI8 {
    const float* sa; const float* sb; Inner inner; int pn_off;
    __device__ __forceinline__ void operator()(const i32x4 (&acc)[2][2][4][2], const pg8::Unit& u, int wr, int wc, int fr, int fq) const {
        const int row0 = u.pm * 256 + wr * 64 + fr, col0 = u.pn * 256 + wc * 32 + 4 * fq;
        f32x4 sbv[2][2]; float sav[2][4];
#pragma unroll
        for (int bj = 0; bj < 2; ++bj)
#pragma unroll
            for (int n = 0; n < 2; ++n) sbv[bj][n] = *(const f32x4*)(sb + col0 + bj * 128 + n * 16);
#pragma unroll
        for (int ai = 0; ai < 2; ++ai)
#pragma unroll
            for (int m = 0; m < 4; ++m) sav[ai][m] = sa[row0 + ai * 128 + m * 16];
        f32x4 f[2][2][4][2];
#pragma unroll
        for (int ai = 0; ai < 2; ++ai)
#pragma unroll
            for (int bj = 0; bj < 2; ++bj)
#pragma unroll
                for (int m = 0; m < 4; ++m)
#pragma unroll
                    for (int n = 0; n < 2; ++n) { const i32x4 q = acc[ai][bj][m][n]; f[ai][bj][m][n] = (f32x4){(float)q.x, (float)q.y, (float)q.z, (float)q.w} * sbv[bj][n] * sav[ai][m]; }
        const pg8::Unit ui{u.pm, u.pn + pn_off};
        inner(f, ui, wr, wc, fr, fq);
    }
};
struct EpiRG {
    const bf16_t* U; float* A; float* BX; const float* ba; const float* bx; const float* ls8;
    __device__ __forceinline__ void operator()(const f32x4 (&acc)[2][2][4][2], const pg8::Unit& u, int wr, int wc, int fr, int fq) const {
        const int row0 = u.pm * 256 + wr * 64 + fr, ch = u.pn * 128 + wc * 32 + fq * 8;
        f32x4 ba4[2], bx4[2], ls4[2];
#pragma unroll
        for (int n = 0; n < 2; ++n) { ba4[n] = *(const f32x4*)(ba + ch + 4 * n); bx4[n] = *(const f32x4*)(bx + ch + 4 * n); ls4[n] = *(const f32x4*)(ls8 + ch + 4 * n); }
#pragma unroll
        for (int ai = 0; ai < 2; ++ai)
#pragma unroll
            for (int m = 0; m < 4; ++m) {
                const int row = row0 + ai * 128 + m * 16; const bool first = (row & (SEQ - 1)) == 0;
                const size_t off = (size_t)row * D + ch;
                const u32x4 uu = *(const u32x4*)(U + off);
                const float uf[8] = {bf_lo(uu.x), bf_hi(uu.x), bf_lo(uu.y), bf_hi(uu.y), bf_lo(uu.z), bf_hi(uu.z), bf_lo(uu.w), bf_hi(uu.w)};
#pragma unroll
                for (int n = 0; n < 2; ++n) {
                    f32x4 av, bv;
#pragma unroll
                    for (int j = 0; j < 4; ++j) {
                        const float r = sigm(acc[ai][0][m][n][j] + ba4[n][j]), ig = sigm(acc[ai][1][m][n][j] + bx4[n][j]);
                        const float a = __expf(r * ls4[n][j]);
                        const float mult = first ? 1.0f : sqrtf(fmaxf(1.0f - a * a, 0.0f));
                        av[j] = a; bv[j] = mult * ig * uf[4 * n + j];
                    }
                    *(f32x4*)(A + off + 4 * n) = av; *(f32x4*)(BX + off + 4 * n) = bv;
                }
            }
    }
};

template <int N> __device__ __forceinline__ float dpp_shr(float v, float ident) {
    return __int_as_float(__builtin_amdgcn_update_dpp(__float_as_int(ident), __float_as_int(v), 0x110 | N, 0xf, 0xf, false));
}
struct EpiRG2 {
    const bf16_t* U; bf16_t* HL; bf16_t* PC; float* AT; float* HT; const float* ba; const float* bx; const float* ls8; LAS float* xch;
    __device__ __forceinline__ void operator()(f32x4 (&acc)[2][2][4][2], const pg8::Unit& u, int wr, int wc, int fr, int fq) const {
        const int ch = u.pn * 128 + wc * 32 + fq * 8, tok0 = u.pm * 256 + 8 * (fr + 16 * wr);
        float hh[8], pp[8];
        {
            f32x4 ba4[2], bx4[2], ls4[2];
#pragma unroll
            for (int n = 0; n < 2; ++n) { ba4[n] = *(const f32x4*)(ba + ch + 4 * n) * -1.4426950408889634f; bx4[n] = *(const f32x4*)(bx + ch + 4 * n) * -1.4426950408889634f; ls4[n] = *(const f32x4*)(ls8 + ch + 4 * n) * 1.4426950408889634f; }
#pragma unroll
            for (int c = 0; c < 8; ++c) { hh[c] = 0.f; pp[c] = 1.f; }
            u32x4 uq[8];
#pragma unroll
            for (int i = 0; i < 8; ++i) uq[i] = *(const u32x4*)((const char*)U + ((unsigned)(tok0 + i) * D + ch) * 2u);
#pragma unroll
            for (int ai = 0; ai < 2; ++ai)
#pragma unroll
                for (int m = 0; m < 4; ++m) {
                    __builtin_amdgcn_sched_barrier(0);
                    const int row = tok0 + 4 * ai + m; const bool first = (row & (SEQ - 1)) == 0;
                    const u32x4 uu = uq[4 * ai + m];
                    const float uf[8] = {bf_lo(uu.x), bf_hi(uu.x), bf_lo(uu.y), bf_hi(uu.y), bf_lo(uu.z), bf_hi(uu.z), bf_lo(uu.w), bf_hi(uu.w)};
#pragma unroll
                    for (int n = 0; n < 2; ++n)
#pragma unroll
                        for (int j = 0; j < 4; ++j) {
                            const int c = 4 * n + j;
                            const float r = __builtin_amdgcn_rcpf(1.0f + __builtin_amdgcn_exp2f(__builtin_fmaf(acc[ai][0][m][n][j], -1.4426950408889634f, ba4[n][j])));
                            const float ig = __builtin_amdgcn_rcpf(1.0f + __builtin_amdgcn_exp2f(__builtin_fmaf(acc[ai][1][m][n][j], -1.4426950408889634f, bx4[n][j])));
                            const float a = __builtin_amdgcn_exp2f(r * ls4[n][j]);
                            float mult = __builtin_amdgcn_sqrtf(__builtin_fmaf(-a, a, 1.0f));
                            if (ai == 0 && m == 0) mult = first ? 1.0f : mult;
                            hh[c] = a * hh[c] + mult * ig * uf[c]; pp[c] *= a;
                            acc[ai][0][m][n][j] = hh[c]; acc[ai][1][m][n][j] = pp[c];
                        }
                }
        }
        float ea[8], eh[8];
#pragma unroll
        for (int c = 0; c < 8; ++c) {
            float ia = pp[c], ih = hh[c], au, hu;
            au = dpp_shr<1>(ia, 1.f); hu = dpp_shr<1>(ih, 0.f); ih = ia * hu + ih; ia = au * ia;
            au = dpp_shr<2>(ia, 1.f); hu = dpp_shr<2>(ih, 0.f); ih = ia * hu + ih; ia = au * ia;
            au = dpp_shr<4>(ia, 1.f); hu = dpp_shr<4>(ih, 0.f); ih = ia * hu + ih; ia = au * ia;
            au = dpp_shr<8>(ia, 1.f); hu = dpp_shr<8>(ih, 0.f); ih = ia * hu + ih; ia = au * ia;
            ea[c] = dpp_shr<1>(ia, 1.f); eh[c] = dpp_shr<1>(ih, 0.f);
            pp[c] = ia; hh[c] = ih;
        }
        LAS float* xw = xch + (wc * 4 + fq) * 16;
        if (wr == 0 && fr == 15) {
#pragma unroll
            for (int c = 0; c < 8; ++c) { xw[2 * c] = pp[c]; xw[2 * c + 1] = hh[c]; }
        }
        asm volatile("s_waitcnt lgkmcnt(0)" ::: "memory");
        __builtin_amdgcn_s_barrier();
        asm volatile("" ::: "memory");
        if (wr == 1) {
#pragma unroll
            for (int c = 0; c < 8; ++c) {
                const float wa = xw[2 * c], wh = xw[2 * c + 1];
                if (fr == 15) { AT[(size_t)u.pm * D + ch + c] = wa * pp[c]; HT[(size_t)u.pm * D + ch + c] = pp[c] * wh + hh[c]; }
                eh[c] = ea[c] * wh + eh[c]; ea[c] = wa * ea[c];
            }
        }
#pragma unroll
        for (int ai = 0; ai < 2; ++ai)
#pragma unroll
            for (int m = 0; m < 4; ++m) {
                const unsigned off = ((unsigned)(tok0 + 4 * ai + m) * D + ch) * 2u;
                float hl[8], pc[8];
#pragma unroll
                for (int n = 0; n < 2; ++n)
#pragma unroll
                    for (int j = 0; j < 4; ++j) { const int c = 4 * n + j; hl[c] = acc[ai][0][m][n][j] + acc[ai][1][m][n][j] * eh[c]; pc[c] = acc[ai][1][m][n][j] * ea[c]; }
                u32x4 w0, w1;
                w0.x = cvt_pk_bf16(hl[0], hl[1]); w0.y = cvt_pk_bf16(hl[2], hl[3]); w0.z = cvt_pk_bf16(hl[4], hl[5]); w0.w = cvt_pk_bf16(hl[6], hl[7]);
                w1.x = cvt_pk_bf16(pc[0], pc[1]); w1.y = cvt_pk_bf16(pc[2], pc[3]); w1.z = cvt_pk_bf16(pc[4], pc[5]); w1.w = cvt_pk_bf16(pc[6], pc[7]);
                *(u32x4*)((char*)HL + off) = w0; *(u32x4*)((char*)PC + off) = w1;
            }
    }
};
struct EpiRes {
    const float* base; float* out; const float* gate;
    __device__ __forceinline__ void operator()(const f32x4 (&acc)[2][2][4][2], const pg8::Unit& u, int wr, int wc, int fr, int fq) const {
        const int row0 = u.pm * 256 + wr * 64 + fr, col0 = u.pn * 256 + wc * 32 + 4 * fq;
        const float* gp = gate + (size_t)(u.pm >> 5) * NMOD + col0;
        f32x4 gv[2][2];
#pragma unroll
        for (int bj = 0; bj < 2; ++bj)
#pragma unroll
            for (int n = 0; n < 2; ++n) gv[bj][n] = *(const f32x4*)(gp + bj * 128 + n * 16);
#pragma unroll
        for (int ai = 0; ai < 2; ++ai)
#pragma unroll
            for (int m = 0; m < 4; ++m) {
                const size_t off = (size_t)(row0 + ai * 128 + m * 16) * D + col0;
#pragma unroll
                for (int bj = 0; bj < 2; ++bj)
#pragma unroll
                    for (int n = 0; n < 2; ++n) { const f32x4 b = *(const f32x4*)(base + off + bj * 128 + n * 16); *(f32x4*)(out + off + bj * 128 + n * 16) = b + gv[bj][n] * acc[ai][bj][m][n]; }
            }
    }
};

template <int MODE, bool Q8 = false> struct EpiResNorm {
    const void* base; void* out; const float* gate; float* rowss; unsigned* cnt; const float* gvec; const float* modb; bf16_t* H; unsigned* rowmx; float* sa2; const float* shmax;
    __device__ __forceinline__ void operator()(f32x4 (&acc)[2][2][4][2], const pg8::Unit& u, int wr, int wc, int fr, int fq) const {
        const int row0 = u.pm * 256 + wr * 64 + fr, colb = u.pn * 256 + wc * 32 + 8 * fq;
        {
            const float* gp = gate + (size_t)(u.pm >> 5) * NMOD + colb;
            f32x4 gv[2][2], gq[2][2], sq[2][2];
#pragma unroll
            for (int bj = 0; bj < 2; ++bj)
#pragma unroll
                for (int n = 0; n < 2; ++n) { gv[bj][n] = *(const f32x4*)(gp + bj * 128 + n * 4);
                    if (Q8) { gq[bj][n] = *(const f32x4*)(gvec + colb + bj * 128 + n * 4) * (*(const f32x4*)(modb + (size_t)(u.pm >> 5) * NMOD + colb + 4096 + bj * 128 + n * 4) + 1.0f);
                        sq[bj][n] = __builtin_elementwise_abs(*(const f32x4*)(modb + (size_t)(u.pm >> 5) * NMOD + colb + 3072 + bj * 128 + n * 4)); } }
#pragma unroll
            for (int ai = 0; ai < 2; ++ai)
#pragma unroll
                for (int m = 0; m < 4; ++m) {
                    const int row = row0 + ai * 128 + m * 16; const unsigned off = ((unsigned)row * D + colb) * 4u;
                    float ss = 0.f, mq = 0.f;
#pragma unroll
                    for (int bj = 0; bj < 2; ++bj) {
                        f32x4 b0, b1;
                        if (MODE == 0) { b0 = *(const f32x4*)((const char*)base + off + bj * 512); b1 = *(const f32x4*)((const char*)base + off + bj * 512 + 16); }
                        else { const u32x4 q = *(const u32x4*)((const char*)base + (off >> 1) + bj * 256); b0 = (f32x4){bf_lo(q.x), bf_hi(q.x), bf_lo(q.y), bf_hi(q.y)}; b1 = (f32x4){bf_lo(q.z), bf_hi(q.z), bf_lo(q.w), bf_hi(q.w)}; }
#pragma unroll
                        for (int n = 0; n < 2; ++n) { const f32x4 v = (n ? b1 : b0) + gv[bj][n] * acc[ai][bj][m][n];
                            acc[ai][bj][m][n] = v; ss += (v.x * v.x + v.y * v.y) + (v.z * v.z + v.w * v.w);
                            if (Q8) { const f32x4 t = __builtin_elementwise_abs(v * gq[bj][n]) + sq[bj][n]; mq = fmaxf(mq, fmaxf(fmaxf(t.x, t.y), fmaxf(t.z, t.w))); } }
                    }
                    ss += __shfl_xor(ss, 16); ss += __shfl_xor(ss, 32);
                    if (Q8) { mq = fmaxf(mq, __shfl_xor(mq, 16)); mq = fmaxf(mq, __shfl_xor(mq, 32)); }
                    if (fq == 0) { (void)__hip_atomic_fetch_add(rowss + row, ss, __ATOMIC_RELAXED, __HIP_MEMORY_SCOPE_AGENT);
                        if (Q8) (void)__hip_atomic_fetch_max(rowmx + row, __float_as_uint(mq), __ATOMIC_RELAXED, __HIP_MEMORY_SCOPE_AGENT); }
                }
        }
        asm volatile("s_waitcnt vmcnt(0)" ::: "memory");
        unsigned* cw = cnt + (2 * u.pm + wr) * 64;
        if (fr == 0 && fq == 0) (void)__hip_atomic_fetch_add(cw, 1u, __ATOMIC_RELAXED, __HIP_MEMORY_SCOPE_AGENT);
        { unsigned spins = 0;
          while ((unsigned)__builtin_amdgcn_readfirstlane(__hip_atomic_load(cw, __ATOMIC_RELAXED, __HIP_MEMORY_SCOPE_AGENT)) < 16u) { __builtin_amdgcn_s_sleep(1); if (++spins > (1u << 17)) break; } }
        asm volatile("" ::: "memory");
        float rs[2][4];
#pragma unroll
        for (int ai = 0; ai < 2; ++ai)
#pragma unroll
            for (int m = 0; m < 4; ++m) rs[ai][m] = rsqrtf(__hip_atomic_load(rowss + row0 + ai * 128 + m * 16, __ATOMIC_RELAXED, __HIP_MEMORY_SCOPE_AGENT) * (1.0f / D) + EPS);
        if (MODE == 1) {
            f32x4 gg[2][2];
#pragma unroll
            for (int bj = 0; bj < 2; ++bj)
#pragma unroll
                for (int n = 0; n < 2; ++n) gg[bj][n] = *(const f32x4*)(gvec + colb + bj * 128 + n * 4);
#pragma unroll
            for (int ai = 0; ai < 2; ++ai)
#pragma unroll
                for (int m = 0; m < 4; ++m) {
                    const unsigned off = ((unsigned)(row0 + ai * 128 + m * 16) * D + colb) * 4u;
#pragma unroll
                    for (int bj = 0; bj < 2; ++bj)
#pragma unroll
                        for (int n = 0; n < 2; ++n) *(f32x4*)((char*)out + off + bj * 512 + n * 16) = acc[ai][bj][m][n] * rs[ai][m] * gg[bj][n];
                }
        } else {
            const float* mb = modb + (size_t)(u.pm >> 5) * NMOD + colb;
            float qinv[2][4];
            if (Q8) { const float shm = shmax[u.pm >> 5];
#pragma unroll
                for (int ai = 0; ai < 2; ++ai)
#pragma unroll
                    for (int m = 0; m < 4; ++m) { const int row = row0 + ai * 128 + m * 16;
                        const float bound = rs[ai][m] * __uint_as_float(__hip_atomic_load(rowmx + row, __ATOMIC_RELAXED, __HIP_MEMORY_SCOPE_AGENT)) + fmaxf(0.0f, 1.0f - rs[ai][m]) * shm;
                        qinv[ai][m] = bound > 0.f ? 127.0f / bound : 0.f;
                        if (u.pn == 0 && wc == 0 && fq == 0) sa2[row] = bound * (1.0f / 127.0f); } }
            f32x4 gs[2][2], sh[2][2];
#pragma unroll
            for (int bj = 0; bj < 2; ++bj)
#pragma unroll
                for (int n = 0; n < 2; ++n) { gs[bj][n] = *(const f32x4*)(gvec + colb + bj * 128 + n * 4) * (*(const f32x4*)(mb + 4096 + bj * 128 + n * 4) + 1.0f); sh[bj][n] = *(const f32x4*)(mb + 3072 + bj * 128 + n * 4); }
#pragma unroll
            for (int ai = 0; ai < 2; ++ai)
#pragma unroll
                for (int m = 0; m < 4; ++m) {
                    const unsigned off = ((unsigned)(row0 + ai * 128 + m * 16) * D + colb) * 4u;
#pragma unroll
                    for (int bj = 0; bj < 2; ++bj) {
                        const f32x4 v0 = acc[ai][bj][m][0], v1 = acc[ai][bj][m][1];
                        u32x4 xw; xw.x = cvt_pk_bf16(v0.x, v0.y); xw.y = cvt_pk_bf16(v0.z, v0.w); xw.z = cvt_pk_bf16(v1.x, v1.y); xw.w = cvt_pk_bf16(v1.z, v1.w);
                        *(u32x4*)((char*)out + (off >> 1) + bj * 256) = xw;
                        const f32x4 y0 = v0 * rs[ai][m] * gs[bj][0] + sh[bj][0], y1 = v1 * rs[ai][m] * gs[bj][1] + sh[bj][1];
                        if (Q8) { const f32x4 q0 = y0 * qinv[ai][m], q1 = y1 * qinv[ai][m];
                            const int a0 = (int)__builtin_rintf(q0.x), a1 = (int)__builtin_rintf(q0.y), a2 = (int)__builtin_rintf(q0.z), a3 = (int)__builtin_rintf(q0.w);
                            const int c0 = (int)__builtin_rintf(q1.x), c1 = (int)__builtin_rintf(q1.y), c2 = (int)__builtin_rintf(q1.z), c3 = (int)__builtin_rintf(q1.w);
                            u32x2 w; w.x = (unsigned)(a0 & 0xff) | ((unsigned)(a1 & 0xff) << 8) | ((unsigned)(a2 & 0xff) << 16) | ((unsigned)a3 << 24);
                            w.y = (unsigned)(c0 & 0xff) | ((unsigned)(c1 & 0xff) << 8) | ((unsigned)(c2 & 0xff) << 16) | ((unsigned)c3 << 24);
                            *(u32x2*)((char*)H + (off >> 2) + bj * 128) = w; }
                        else { u32x4 w; w.x = cvt_pk_bf16(y0.x, y0.y); w.y = cvt_pk_bf16(y0.z, y0.w); w.z = cvt_pk_bf16(y1.x, y1.y); w.w = cvt_pk_bf16(y1.z, y1.w); *(u32x4*)((char*)H + (off >> 1) + bj * 256) = w; }
                    }
                }
        }
    }
};
struct EpiConvA {
    bf16_t* YA; bf16_t* PT; bf16_t* ST; const float* cw;
    __device__ __forceinline__ void operator()(f32x4 (&acc)[2][2][4][2], const pg8::Unit& u, int wr, int wc, int fr, int fq) const {
        const int ch = u.pn * 64 + wc * 16 + fq * 4, tok0 = u.pm * 256 + 8 * (fr + 16 * wr), hb = 2 * u.pm + wr;
        const f32x4 w0 = *(const f32x4*)(cw + ch), w1 = *(const f32x4*)(cw + D + ch), w2 = *(const f32x4*)(cw + 2 * D + ch);
#pragma unroll
        for (int ai = 0; ai < 2; ++ai)
#pragma unroll
            for (int m = 0; m < 4; ++m) {
                const f32x4 cb = acc[ai][0][m][0], cc = acc[ai][0][m][1], cx = acc[ai][1][m][0], ga = acc[ai][1][m][1];
                f32x4 sv;
#pragma unroll
                for (int j = 0; j < 4; ++j) sv[j] = sigm(ga[j]) * cb[j];
                acc[ai][0][m][0] = sv; acc[ai][0][m][1] = cc * cx;
            }
        const f32x4 p6 = acc[1][0][2][1], p7 = acc[1][0][3][1];
        f32x4 a, b;
#pragma unroll
        for (int j = 0; j < 4; ++j) { a[j] = dpp_shr<1>(p6[j], 0.f); b[j] = dpp_shr<1>(p7[j], 0.f); }
        if (fr == 15) { u32x2 q6, q7; q6.x = cvt_pk_bf16(p6.x, p6.y); q6.y = cvt_pk_bf16(p6.z, p6.w); q7.x = cvt_pk_bf16(p7.x, p7.y); q7.y = cvt_pk_bf16(p7.z, p7.w);
            *(u32x2*)(PT + (size_t)(hb * 2 + 0) * D + ch) = q6; *(u32x2*)(PT + (size_t)(hb * 2 + 1) * D + ch) = q7; }
        if (fr == 0) { const f32x4 s0 = acc[0][0][0][0], s1 = acc[0][0][1][0]; u32x2 q0, q1; q0.x = cvt_pk_bf16(s0.x, s0.y); q0.y = cvt_pk_bf16(s0.z, s0.w); q1.x = cvt_pk_bf16(s1.x, s1.y); q1.y = cvt_pk_bf16(s1.z, s1.w);
            *(u32x2*)(ST + (size_t)(hb * 2 + 0) * D + ch) = q0; *(u32x2*)(ST + (size_t)(hb * 2 + 1) * D + ch) = q1; }
#pragma unroll
        for (int ai = 0; ai < 2; ++ai)
#pragma unroll
            for (int m = 0; m < 4; ++m) {
                const f32x4 pc = acc[ai][0][m][1], y = acc[ai][0][m][0] * (w0 * a + w1 * b + w2 * pc);
                u32x2 w; w.x = cvt_pk_bf16(y.x, y.y); w.y = cvt_pk_bf16(y.z, y.w);
                *(u32x2*)((char*)YA + ((unsigned)(tok0 + 4 * ai + m) * D + ch) * 2u) = w;
                a = b; b = pc;
            }
    }
};

struct EpiConvC {
    const float* sa; const float* sb; bf16_t* U; bf16_t* RXS; const float* cw; const float* cbias;
    __device__ __forceinline__ void operator()(const i32x4 (&acc)[2][2][4][2], const pg8::Unit& u, int wr, int wc, int fr, int fq) const {
        const int tok0 = u.pm * 256 + 8 * (fr + 16 * wr), hb = 2 * u.pm + wr, col0 = u.pn * 256 + wc * 32 + 4 * fq;
        float sav[8];
#pragma unroll
        for (int i = 0; i < 8; ++i) sav[i] = sa[tok0 + i];
#pragma unroll
        for (int bj = 0; bj < 2; ++bj) {
            u32x2 vq[8];
#pragma unroll
            for (int n = 0; n < 2; ++n) {
                __builtin_amdgcn_sched_barrier(0);
                const int ch = u.pn * 256 + bj * 128 + wc * 32 + fq * 8 + 4 * n;
                const f32x4 sbn = *(const f32x4*)(sb + col0 + bj * 128 + n * 16);
                const f32x4 w0 = *(const f32x4*)(cw + ch), w1 = *(const f32x4*)(cw + D + ch), w2 = *(const f32x4*)(cw + 2 * D + ch), w3 = *(const f32x4*)(cw + 3 * D + ch), bb = *(const f32x4*)(cbias + ch);
                f32x4 r[8];
#pragma unroll
                for (int ai = 0; ai < 2; ++ai)
#pragma unroll
                    for (int m = 0; m < 4; ++m) { const i32x4 q = acc[ai][bj][m][n]; r[4 * ai + m] = (f32x4){(float)q.x, (float)q.y, (float)q.z, (float)q.w} * sbn * sav[4 * ai + m]; }
                f32x4 pv[3];
#pragma unroll
                for (int k = 0; k < 3; ++k)
#pragma unroll
                    for (int j = 0; j < 4; ++j) pv[k][j] = dpp_shr<1>(r[5 + k][j], 0.f);
                if (fr == 0 || fr == 15) {
#pragma unroll
                    for (int k = 0; k < 3; ++k) { const f32x4 x = (fr == 0) ? r[k] : r[5 + k]; u32x2 q; q.x = cvt_pk_bf16(x.x, x.y); q.y = cvt_pk_bf16(x.z, x.w);
                        *(u32x2*)(RXS + (size_t)(hb * 6 + (fr == 0 ? k : 3 + k)) * D + ch) = q; }
                }
#pragma unroll
                for (int i = 0; i < 8; ++i) {
                    const f32x4 x3 = (i >= 3) ? r[i >= 3 ? i - 3 : 0] : pv[i >= 3 ? 0 : i];
                    const f32x4 x2 = (i >= 2) ? r[i >= 2 ? i - 2 : 0] : pv[i >= 2 ? 0 : i + 1];
                    const f32x4 x1 = (i >= 1) ? r[i >= 1 ? i - 1 : 0] : pv[2];
                    const f32x4 v = bb + w0 * x3 + w1 * x2 + w2 * x1 + w3 * r[i];
                    u32x2 q; q.x = cvt_pk_bf16(v.x, v.y); q.y = cvt_pk_bf16(v.z, v.w);
                    if (n == 0) vq[i] = q;
                    else *(u32x4*)((char*)U + ((unsigned)(tok0 + i) * D + ch - 4) * 2u) = (u32x4){vq[i].x, vq[i].y, q.x, q.y};
                }
            }
        }
    }
};

struct EpiRG3 {
    const bf16_t* U; bf16_t* MERGED; unsigned long long* TOT; unsigned* FLAG; const float* ba; const float* bx; const float* ls8; LAS float* xch;
    const bf16_t* YA; const bf16_t* G2; const bf16_t* PT; const bf16_t* ST; const float* cw;
    __device__ __forceinline__ void operator()(f32x4 (&acc)[2][2][4][2], const pg8::Unit& u, int wr, int wc, int fr_, int fq_) const {
        int fr = fr_, fq = fq_; asm volatile("" : "+v"(fr), "+v"(fq));
        const int ch = u.pn * 128 + wc * 32 + fq * 8, tok0 = u.pm * 256 + 8 * (fr + 16 * wr);
        float hh[8], pp[8];
        {
            f32x4 ba4[2], bx4[2], ls4[2];
#pragma unroll
            for (int n = 0; n < 2; ++n) { ba4[n] = *(const f32x4*)((const char*)ba + (unsigned)(ch + 4 * n) * 4u) * -1.4426950408889634f; bx4[n] = *(const f32x4*)((const char*)bx + (unsigned)(ch + 4 * n) * 4u) * -1.4426950408889634f; ls4[n] = *(const f32x4*)((const char*)ls8 + (unsigned)(ch + 4 * n) * 4u) * 1.4426950408889634f; }
#pragma unroll
            for (int c = 0; c < 8; ++c) { hh[c] = 0.f; pp[c] = 1.f; }
            u32x4 uq[8];
#pragma unroll
            for (int i = 0; i < 8; ++i) uq[i] = *(const u32x4*)((const char*)U + ((unsigned)(tok0 + i) * D + ch) * 2u);
#pragma unroll
            for (int ai = 0; ai < 2; ++ai)
#pragma unroll
                for (int m = 0; m < 4; ++m) {
                    __builtin_amdgcn_sched_barrier(0);
                    const int row = tok0 + 4 * ai + m; const bool first = (row & (SEQ - 1)) == 0;
                    const u32x4 uu = uq[4 * ai + m];
                    const float uf[8] = {bf_lo(uu.x), bf_hi(uu.x), bf_lo(uu.y), bf_hi(uu.y), bf_lo(uu.z), bf_hi(uu.z), bf_lo(uu.w), bf_hi(uu.w)};
#pragma unroll
                    for (int n = 0; n < 2; ++n)
#pragma unroll
                        for (int j = 0; j < 4; ++j) {
                            const int c = 4 * n + j;
                            const float r = __builtin_amdgcn_rcpf(1.0f + __builtin_amdgcn_exp2f(__builtin_fmaf(acc[ai][0][m][n][j], -1.4426950408889634f, ba4[n][j])));
                            const float ig = __builtin_amdgcn_rcpf(1.0f + __builtin_amdgcn_exp2f(__builtin_fmaf(acc[ai][1][m][n][j], -1.4426950408889634f, bx4[n][j])));
                            const float a = __builtin_amdgcn_exp2f(r * ls4[n][j]);
                            float mult = __builtin_amdgcn_sqrtf(__builtin_fmaf(-a, a, 1.0f));
                            if (ai == 0 && m == 0) mult = first ? 1.0f : mult;
                            hh[c] = a * hh[c] + mult * ig * uf[c]; pp[c] *= a;
                            acc[ai][0][m][n][j] = hh[c]; acc[ai][1][m][n][j] = pp[c];
                        }
                }
        }
        __builtin_amdgcn_sched_barrier(0);
        float ea[8], eh[8];
#pragma unroll
        for (int c = 0; c < 8; ++c) {
            float ia = pp[c], ih = hh[c], au, hu;
            au = dpp_shr<1>(ia, 1.f); hu = dpp_shr<1>(ih, 0.f); ih = ia * hu + ih; ia = au * ia;
            au = dpp_shr<2>(ia, 1.f); hu = dpp_shr<2>(ih, 0.f); ih = ia * hu + ih; ia = au * ia;
            au = dpp_shr<4>(ia, 1.f); hu = dpp_shr<4>(ih, 0.f); ih = ia * hu + ih; ia = au * ia;
            au = dpp_shr<8>(ia, 1.f); hu = dpp_shr<8>(ih, 0.f); ih = ia * hu + ih; ia = au * ia;
            ea[c] = dpp_shr<1>(ia, 1.f); eh[c] = dpp_shr<1>(ih, 0.f);
            pp[c] = ia; hh[c] = ih;
        }
        LAS float* xw = xch + (wc * 4 + fq) * 16;
        if (wr == 0 && fr == 15) {
#pragma unroll
            for (int c = 0; c < 8; ++c) { xw[2 * c] = pp[c]; xw[2 * c + 1] = hh[c]; }
        }
        asm volatile("s_waitcnt lgkmcnt(0)" ::: "memory");
        __builtin_amdgcn_s_barrier();
        asm volatile("" ::: "memory");
        if (wr == 1) {
#pragma unroll
            for (int c = 0; c < 8; ++c) {
                const float wa = xw[2 * c], wh = xw[2 * c + 1];
                if (fr == 15) { const float ta = wa * pp[c], th = pp[c] * wh + hh[c];
                    __hip_atomic_store((unsigned long long*)((char*)TOT + ((unsigned)(u.pm * D + ch + c)) * 8u), ((unsigned long long)__float_as_uint(th) << 32) | __float_as_uint(ta), __ATOMIC_RELAXED, __HIP_MEMORY_SCOPE_AGENT); }
                eh[c] = ea[c] * wh + eh[c]; ea[c] = wa * ea[c];
            }
            asm volatile("s_waitcnt vmcnt(0)" ::: "memory");
            if (fr == 15 && fq == 0) (void)__hip_atomic_fetch_add((unsigned*)((char*)FLAG + (unsigned)(u.pm * 8 + u.pn) * 4u), 1u, __ATOMIC_RELAXED, __HIP_MEMORY_SCOPE_AGENT);
        }
        __builtin_amdgcn_sched_barrier(0);
        {
            const int kb = u.pm & 31;
            float ca[8], chh[8];
#pragma unroll
            for (int c = 0; c < 8; ++c) { ca[c] = 1.f; chh[c] = 0.f; }
#pragma unroll
            for (int q = 0; q < 2; ++q) {
                const int pidx = 2 * fr + q;
                if (pidx < kb) {
                    const int k = u.pm - kb + pidx; unsigned spins = 0;
                    while (__hip_atomic_load((const unsigned*)((const char*)FLAG + (unsigned)(k * 8 + u.pn) * 4u), __ATOMIC_RELAXED, __HIP_MEMORY_SCOPE_AGENT) < 4u) { __builtin_amdgcn_s_sleep(1); if (++spins > (1u << 16)) break; }
#pragma unroll
                    for (int c = 0; c < 8; ++c) { const unsigned long long w = __hip_atomic_load((const unsigned long long*)((const char*)TOT + ((unsigned)(k * D + ch + c)) * 8u), __ATOMIC_RELAXED, __HIP_MEMORY_SCOPE_AGENT);
                        const float ta = __uint_as_float((unsigned)w), th = __uint_as_float((unsigned)(w >> 32)); chh[c] = ta * chh[c] + th; ca[c] = ta * ca[c]; }
                }
            }
#pragma unroll
            for (int c = 0; c < 8; ++c) {
                float ia = ca[c], ih = chh[c], au, hu;
                au = dpp_shr<1>(ia, 1.f); hu = dpp_shr<1>(ih, 0.f); ih = ia * hu + ih; ia = au * ia;
                au = dpp_shr<2>(ia, 1.f); hu = dpp_shr<2>(ih, 0.f); ih = ia * hu + ih; ia = au * ia;
                au = dpp_shr<4>(ia, 1.f); hu = dpp_shr<4>(ih, 0.f); ih = ia * hu + ih; ia = au * ia;
                au = dpp_shr<8>(ia, 1.f); hu = dpp_shr<8>(ih, 0.f); ih = ia * hu + ih; ia = au * ia;
                const float carry = __shfl(ih, fq * 16 + 15);
                eh[c] = __builtin_fmaf(ea[c], carry, eh[c]);
            }
        }
        __builtin_amdgcn_sched_barrier(0);
        u32x4 qy[4], qg[4];
#pragma unroll
        for (int i = 0; i < 4; ++i) { const unsigned off = ((unsigned)(tok0 + i) * D + ch) * 2u; qy[i] = *(const u32x4*)((const char*)YA + off); qg[i] = *(const u32x4*)((const char*)G2 + off); }
#pragma unroll
        for (int half = 0; half < 2; ++half) {
            __builtin_amdgcn_sched_barrier(0);
            u32x4 ny[4], ng[4];
            if (half == 0) {
#pragma unroll
                for (int i = 0; i < 4; ++i) { const unsigned off = ((unsigned)(tok0 + 4 + i) * D + ch) * 2u; ny[i] = *(const u32x4*)((const char*)YA + off); ng[i] = *(const u32x4*)((const char*)G2 + off); }
            }
#pragma unroll
            for (int m = 0; m < 4; ++m) {
                const int ai = half, i = 4 * ai + m; const unsigned off = ((unsigned)(tok0 + i) * D + ch) * 2u;
                const unsigned yw[4] = {qy[m].x, qy[m].y, qy[m].z, qy[m].w}, gw4[4] = {qg[m].x, qg[m].y, qg[m].z, qg[m].w};
                unsigned ow[4];
#pragma unroll
                for (int q = 0; q < 4; ++q) {
                    const int c0 = 2 * q, c1 = 2 * q + 1, n0 = c0 >> 2, j0 = c0 & 3, n1 = c1 >> 2, j1 = c1 & 3;
                    const float h0 = acc[ai][0][m][n0][j0] + acc[ai][1][m][n0][j0] * eh[c0], h1 = acc[ai][0][m][n1][j1] + acc[ai][1][m][n1][j1] * eh[c1];
                    float m0 = bf_lo(yw[q]) + h0 * bf_lo(gw4[q]), m1 = bf_hi(yw[q]) + h1 * bf_hi(gw4[q]);
                    ow[q] = cvt_pk_bf16(m0, m1);
                }
                *(u32x4*)((char*)MERGED + off) = (u32x4){ow[0], ow[1], ow[2], ow[3]};
            }
            if (half == 0) {
#pragma unroll
                for (int i = 0; i < 4; ++i) { qy[i] = ny[i]; qg[i] = ng[i]; }
            }
        }
    }
};
struct EpiGU {
    bf16_t* ACT;
    __device__ __forceinline__ void operator()(const f32x4 (&acc)[2][2][4][2], const pg8::Unit& u, int wr, int wc, int fr, int fq) const {
        const int row0 = u.pm * 256 + wr * 64 + fr, ch = u.pn * 128 + wc * 32 + fq * 8;
#pragma unroll
        for (int ai = 0; ai < 2; ++ai)
#pragma unroll
            for (int m = 0; m < 4; ++m) {
                const size_t off = (size_t)(row0 + ai * 128 + m * 16) * FF + ch;
                float v[8];
#pragma unroll
                for (int n = 0; n < 2; ++n)
#pragma unroll
                    for (int j = 0; j < 4; ++j) { const float g = acc[ai][0][m][n][j]; v[4 * n + j] = g * sigm(g) * acc[ai][1][m][n][j]; }
                u32x4 w; w.x = cvt_pk_bf16(v[0], v[1]); w.y = cvt_pk_bf16(v[2], v[3]); w.z = cvt_pk_bf16(v[4], v[5]); w.w = cvt_pk_bf16(v[6], v[7]);
                *(u32x4*)(ACT + off) = w;
            }
    }
};

__device__ __forceinline__ int map_in(int n) {
    const int q = n >> 10, ch = n & 1023;
    if (q == 3) return 6144 + (ch & ~127) + slot8(ch & 127);
    if (q == 4 || q == 6) return 4096 + (ch >> 7) * 256 + (q == 6 ? 128 : 0) + slot8(ch & 127);
    const int s = (q == 5) ? 3 : q;
    return (ch >> 6) * 256 + 128 * (s >> 1) + 32 * ((ch >> 4) & 3) + 16 * (s & 1) + (ch & 15);
}
__device__ __forceinline__ int map_gu(int n) { const int s = n >= FF ? 1 : 0, ch = n - s * FF; return (ch >> 7) * 256 + 128 * s + slot8(ch & 127); }
__device__ __forceinline__ int map_rg(int h, int s, int jc) { return (2 * h + (jc >> 7)) * 256 + 128 * s + slot8(jc & 127); }

__device__ __forceinline__ void tr_item(const float* src, int ldn, int k0, int n0, bf16_t* dst, int ldk, LAS float* scr, int lane, int kind, int aux) {
    float tv[32];
#pragma unroll
    for (int i = 0; i < 32; ++i) { const int kk = 2 * i + (lane >> 5); tv[i] = src[(size_t)(k0 + kk) * ldn + n0 + (lane & 31)]; }
#pragma unroll
    for (int i = 0; i < 32; ++i) { const int kk = 2 * i + (lane >> 5); scr[kk * 33 + (lane & 31)] = tv[i]; }
    asm volatile("s_waitcnt lgkmcnt(0)" ::: "memory");
    const int kp = lane & 31;
#pragma unroll 4
    for (int i = 0; i < 16; ++i) {
        const int jn = 2 * i + (lane >> 5), n = n0 + jn;
        const float v0 = scr[(2 * kp) * 33 + jn], v1 = scr[(2 * kp + 1) * 33 + jn];
        int row;
        if (kind == 0) row = map_in(n); else if (kind == 1) row = map_gu(n); else if (kind == 2) row = (n & ~127) | slot8(n & 127); else row = map_rg(aux >> 1, aux & 1, n);
        *(unsigned*)(dst + (size_t)row * ldk + k0 + 2 * kp) = cvt_pk_bf16(v0, v1);
    }
    asm volatile("s_waitcnt lgkmcnt(0)" ::: "memory");
}

__device__ __forceinline__ void norm_rows_bf16(const float* X, const float* g, const float* mod, int shoff, int scoff, bf16_t* H, int gw, int NGW, int lane) {
    for (int row = gw; row < M; row += NGW) {
        const float* mb = mod + (size_t)(row >> 13) * NMOD;
        const f32x4* xr = (const f32x4*)(X + (size_t)row * D) + lane;
        f32x4 v[4]; float s = 0.f;
#pragma unroll
        for (int j = 0; j < 4; ++j) { v[j] = xr[64 * j]; s += (v[j].x * v[j].x + v[j].y * v[j].y) + (v[j].z * v[j].z + v[j].w * v[j].w); }
        const float rstd = rsqrtf(wave_sum(s) * (1.0f / D) + EPS);
        u32x2* o = (u32x2*)(H + (size_t)row * D) + lane;
#pragma unroll
        for (int j = 0; j < 4; ++j) {
            const int col = 4 * (lane + 64 * j);
            const f32x4 g4 = *(const f32x4*)(g + col), sc4 = *(const f32x4*)(mb + scoff + col), sh4 = *(const f32x4*)(mb + shoff + col);
            const f32x4 y = v[j] * rstd * g4 * (sc4 + 1.0f) + sh4;
            u32x2 w; w.x = cvt_pk_bf16(y.x, y.y); w.y = cvt_pk_bf16(y.z, y.w); o[64 * j] = w;
        }
    }
}


__device__ __forceinline__ void amax_item(const float* src, int ldn, int k0, int n0, unsigned* cmax, int lane) {
    float mx = 0.f;
#pragma unroll
    for (int i = 0; i < 32; ++i) { const int kk = 2 * i + (lane >> 5); mx = fmaxf(mx, fabsf(src[(size_t)(k0 + kk) * ldn + n0 + (lane & 31)])); }
    mx = fmaxf(mx, __shfl_xor(mx, 32));
    if (lane < 32) (void)__hip_atomic_fetch_max(cmax + n0 + lane, __float_as_uint(mx), __ATOMIC_RELAXED, __HIP_MEMORY_SCOPE_AGENT);
}
__device__ __forceinline__ void q_item(const float* src, int ldn, int k0, int n0, signed char* dst, int ldk, unsigned* cmax, float* sb, LAS float* scr, int lane, int kind) {
    float tv[32];
#pragma unroll
    for (int i = 0; i < 32; ++i) { const int kk = 2 * i + (lane >> 5); tv[i] = src[(size_t)(k0 + kk) * ldn + n0 + (lane & 31)]; }
#pragma unroll
    for (int i = 0; i < 32; ++i) { const int kk = 2 * i + (lane >> 5); scr[kk * 33 + (lane & 31)] = tv[i]; }
    asm volatile("s_waitcnt lgkmcnt(0)" ::: "memory");
    const int kq = lane & 15;
#pragma unroll 2
    for (int i = 0; i < 8; ++i) {
        const int jn = 4 * i + (lane >> 4), n = n0 + jn;
        const float cm = __uint_as_float(__hip_atomic_load(cmax + n, __ATOMIC_RELAXED, __HIP_MEMORY_SCOPE_AGENT));
        const float inv = cm > 0.f ? 127.0f / cm : 0.f;
        const int q0 = (int)__builtin_rintf(scr[(4 * kq + 0) * 33 + jn] * inv), q1 = (int)__builtin_rintf(scr[(4 * kq + 1) * 33 + jn] * inv),
                  q2 = (int)__builtin_rintf(scr[(4 * kq + 2) * 33 + jn] * inv), q3 = (int)__builtin_rintf(scr[(4 * kq + 3) * 33 + jn] * inv);
        const int row = (kind == 0) ? map_in(n) : (kind == 1 ? map_gu(n) : map_in(n) - 4096);
        *(unsigned*)(dst + (size_t)row * ldk + k0 + 4 * kq) = (unsigned)(q0 & 0xff) | ((unsigned)(q1 & 0xff) << 8) | ((unsigned)(q2 & 0xff) << 16) | ((unsigned)q3 << 24);
        if (k0 == 0 && kq == 0) sb[row] = cm * (1.0f / 127.0f);
    }
    asm volatile("s_waitcnt lgkmcnt(0)" ::: "memory");
}
__device__ __forceinline__ float wave_max(float v) {
#pragma unroll
    for (int o = 32; o >= 1; o >>= 1) v = fmaxf(v, __shfl_xor(v, o));
    return v;
}
__device__ __forceinline__ void norm_rows_i8(const float* X, const float* g, const float* mod, int shoff, int scoff, signed char* Hq, float* sa, bf16_t* Hb, int gw, int NGW, int lane) {
    for (int row = gw; row < M; row += NGW) {
        const float* mb = mod + (size_t)(row >> 13) * NMOD;
        const f32x4* xr = (const f32x4*)(X + (size_t)row * D) + lane;
        f32x4 v[4]; float s = 0.f;
#pragma unroll
        for (int j = 0; j < 4; ++j) { v[j] = xr[64 * j]; s += (v[j].x * v[j].x + v[j].y * v[j].y) + (v[j].z * v[j].z + v[j].w * v[j].w); }
        const float rstd = rsqrtf(wave_sum(s) * (1.0f / D) + EPS);
        float mx = 0.f;
#pragma unroll
        for (int j = 0; j < 4; ++j) {
            const int col = 4 * (lane + 64 * j);
            const f32x4 g4 = *(const f32x4*)(g + col), sc4 = *(const f32x4*)(mb + scoff + col), sh4 = *(const f32x4*)(mb + shoff + col);
            v[j] = v[j] * rstd * g4 * (sc4 + 1.0f) + sh4;
            mx = fmaxf(mx, fmaxf(fmaxf(fabsf(v[j].x), fabsf(v[j].y)), fmaxf(fabsf(v[j].z), fabsf(v[j].w))));
        }
        mx = wave_max(mx);
        const float inv = mx > 0.f ? 127.0f / mx : 0.f;
        unsigned* o = (unsigned*)(Hq + (size_t)row * D) + lane;
#pragma unroll
        for (int j = 0; j < 4; ++j) {
            const int q0 = (int)__builtin_rintf(v[j].x * inv), q1 = (int)__builtin_rintf(v[j].y * inv), q2 = (int)__builtin_rintf(v[j].z * inv), q3 = (int)__builtin_rintf(v[j].w * inv);
            o[64 * j] = (unsigned)(q0 & 0xff) | ((unsigned)(q1 & 0xff) << 8) | ((unsigned)(q2 & 0xff) << 16) | ((unsigned)q3 << 24);
            if (Hb) { u32x2 w; w.x = cvt_pk_bf16(v[j].x, v[j].y); w.y = cvt_pk_bf16(v[j].z, v[j].w); ((u32x2*)(Hb + (size_t)row * D) + lane)[64 * j] = w; }
        }
        if (lane == 0) sa[row] = mx * (1.0f / 127.0f);
    }
}

__device__ __forceinline__ void conv_fix_item(int hb, int c8, bool doU, bool doYA, const float* conv_b_w, const float* conv_b_bias, const float* conv_a_w, const bf16_t* RXS, bf16_t* U, bf16_t* YA, const bf16_t* PT, const bf16_t* ST) {
    const int t0 = hb * 128;
    if (doU) {
        u32x4 x[6];
#pragma unroll
        for (int k = 0; k < 3; ++k) { x[k] = *(const u32x4*)(RXS + (size_t)((hb - 1) * 6 + 3 + k) * D + c8); x[3 + k] = *(const u32x4*)(RXS + (size_t)(hb * 6 + k) * D + c8); }
        float w[4][8], bb[8];
#pragma unroll
        for (int k = 0; k < 4; ++k)
#pragma unroll
            for (int j = 0; j < 8; ++j) w[k][j] = conv_b_w[k * D + c8 + j];
#pragma unroll
        for (int j = 0; j < 8; ++j) bb[j] = conv_b_bias[c8 + j];
#pragma unroll
        for (int o = 0; o < 3; ++o) {
            float v[8];
#pragma unroll
            for (int j = 0; j < 8; ++j) v[j] = bb[j];
#pragma unroll
            for (int k = 0; k < 4; ++k) { const u32x4 q = x[o + k];
                v[0] += w[k][0] * bf_lo(q.x); v[1] += w[k][1] * bf_hi(q.x); v[2] += w[k][2] * bf_lo(q.y); v[3] += w[k][3] * bf_hi(q.y);
                v[4] += w[k][4] * bf_lo(q.z); v[5] += w[k][5] * bf_hi(q.z); v[6] += w[k][6] * bf_lo(q.w); v[7] += w[k][7] * bf_hi(q.w); }
            u32x4 wv; wv.x = cvt_pk_bf16(v[0], v[1]); wv.y = cvt_pk_bf16(v[2], v[3]); wv.z = cvt_pk_bf16(v[4], v[5]); wv.w = cvt_pk_bf16(v[6], v[7]);
            *(u32x4*)(U + (size_t)(t0 + o) * D + c8) = wv;
        }
    }
    if (doYA) {
        const u32x4 s0 = *(const u32x4*)(ST + (size_t)(hb * 2 + 0) * D + c8), s1 = *(const u32x4*)(ST + (size_t)(hb * 2 + 1) * D + c8);
        const u32x4 pa = *(const u32x4*)(PT + (size_t)((hb - 1) * 2 + 0) * D + c8), pb = *(const u32x4*)(PT + (size_t)((hb - 1) * 2 + 1) * D + c8);
        const u32x4 y0 = *(const u32x4*)(YA + (size_t)t0 * D + c8), y1 = *(const u32x4*)(YA + (size_t)(t0 + 1) * D + c8);
        const unsigned s0w[4] = {s0.x, s0.y, s0.z, s0.w}, s1w[4] = {s1.x, s1.y, s1.z, s1.w}, paw[4] = {pa.x, pa.y, pa.z, pa.w}, pbw[4] = {pb.x, pb.y, pb.z, pb.w}, y0w[4] = {y0.x, y0.y, y0.z, y0.w}, y1w[4] = {y1.x, y1.y, y1.z, y1.w};
        unsigned o0[4], o1[4];
#pragma unroll
        for (int q = 0; q < 4; ++q) {
            const int j0 = 2 * q, j1 = 2 * q + 1;
            const float w00 = conv_a_w[c8 + j0], w01 = conv_a_w[c8 + j1], w10 = conv_a_w[D + c8 + j0], w11 = conv_a_w[D + c8 + j1];
            o0[q] = cvt_pk_bf16(bf_lo(y0w[q]) + bf_lo(s0w[q]) * (w00 * bf_lo(paw[q]) + w10 * bf_lo(pbw[q])), bf_hi(y0w[q]) + bf_hi(s0w[q]) * (w01 * bf_hi(paw[q]) + w11 * bf_hi(pbw[q])));
            o1[q] = cvt_pk_bf16(bf_lo(y1w[q]) + bf_lo(s1w[q]) * (w00 * bf_lo(pbw[q])), bf_hi(y1w[q]) + bf_hi(s1w[q]) * (w01 * bf_hi(pbw[q])));
        }
        *(u32x4*)(YA + (size_t)t0 * D + c8) = (u32x4){o0[0], o0[1], o0[2], o0[3]}; *(u32x4*)(YA + (size_t)(t0 + 1) * D + c8) = (u32x4){o1[0], o1[1], o1[2], o1[3]};
    }
}

struct Params { const float* in[19]; float* out; unsigned char* ws; };

__global__ void __launch_bounds__(512, 2) fwd_megakernel(Params P) {
    extern __shared__ __attribute__((aligned(16))) unsigned char lds_raw[];
    LAS unsigned char* lds = (LAS unsigned char*)lds_raw;
    cg::grid_group grid = cg::this_grid();
    const int G = gridDim.x, bid = blockIdx.x;
    const int cid = (G == 256) ? ((bid & 31) * 8 + (bid >> 5)) : bid;
#define KARG(i) ({ const __attribute__((address_space(4))) char* _k = (const __attribute__((address_space(4))) char*)__builtin_amdgcn_kernarg_segment_ptr(); asm volatile("" : "+s"(_k)); *(const float* const __attribute__((address_space(4)))*)(_k + 8 * (i)); })
#define PHASE_IDS() int tid = threadIdx.x; asm volatile("" : "+v"(tid)); const int lane = tid & 63, wave = __builtin_amdgcn_readfirstlane(tid >> 6), gw = bid * 8 + wave, NGW = G * 8; (void)lane; (void)gw; (void)NGW
#define WSP(T, off) ((T*)((unsigned char*)KARG(20) + (off)))
#define OUTP ((float*)KARG(19))
#define GRID_BAR() do { XcdBarrier _b; _b.bar = WSP(unsigned, WS_BAR); _b.x = xb_xcc_id(); _b.st = (volatile LAS unsigned*)(lds + 131072); xcd_barrier(_b); } while (0)
    if (threadIdx.x < 4) ((LAS unsigned*)(lds + 131072))[threadIdx.x] = 0u;
    __syncthreads();
    xcd_barrier_post(WSP(unsigned, WS_BAR));
    for (int pass = 0; pass < NPASS; ++pass) {
    for (int rep = 0; rep < REP0; ++rep)
    {
        PHASE_IDS();
        const float* c = KARG(1); const float* w_ada = KARG(2); const float* b_ada = KARG(3); const float* lam = KARG(13);
        float* MOD = WSP(float, WS_MOD); float* LS8 = WSP(float, WS_LS8);
        LAS float* scl = (LAS float*)(lds + 98304);
        LAS float* red = (LAS float*)(lds + 98304 + 16384);
        for (int i = tid; i < 4096; i += 512) { const float v = c[i]; scl[i] = v / (1.0f + __expf(-v)); }
        __syncthreads();
        if (bid == G - 1) for (int i = tid; i < D; i += 512) LS8[i] = -8.0f * log1pf(expf(-lam[i]));
        LAS float* scr = (LAS float*)(lds + wave * 8448);
        constexpr int B_MOD = NMOD / 32, B_IN = 16 * (NIN / 256), B_GU = 16 * (NGU / 256), B_DN = (FF / 64) * (D / 256), B_OUT = 16 * (D / 256), B_RG = 2 * 4 * 4;
        for (int bi = bid; bi < B_MOD + B_IN + B_GU + B_DN + B_OUT + B_RG; bi += G) {
            int r = bi;
            if (r < B_MOD) {
                const int col = lane & 31, n = r * 32 + col, k0 = wave * 128 + (lane >> 5);
                float a0 = 0.f, a1 = 0.f, a2 = 0.f, a3 = 0.f;
#pragma unroll 16
                for (int k = 0; k < 128; k += 2) { const float w = w_ada[(size_t)(k0 + k) * NMOD + n]; a0 += scl[k0 + k] * w; a1 += scl[1024 + k0 + k] * w; a2 += scl[2048 + k0 + k] * w; a3 += scl[3072 + k0 + k] * w; }
                a0 += __shfl_xor(a0, 32); a1 += __shfl_xor(a1, 32); a2 += __shfl_xor(a2, 32); a3 += __shfl_xor(a3, 32);
                __syncthreads();
                if (lane < 32) { red[(wave * 4 + 0) * 32 + col] = a0; red[(wave * 4 + 1) * 32 + col] = a1; red[(wave * 4 + 2) * 32 + col] = a2; red[(wave * 4 + 3) * 32 + col] = a3; }
                __syncthreads();
                if (tid < 128) { const int b = tid >> 5; float s = b_ada[r * 32 + col];
#pragma unroll
                    for (int w = 0; w < 8; ++w) s += red[(w * 4 + b) * 32 + col];
                    MOD[(size_t)b * NMOD + r * 32 + col] = s; }
                continue;
            }
            r -= B_MOD;
            if (r < B_IN) { const int part = r >> 6;
                            const bool i8 = (P2_I8 == 1) || (P2_I8 == 2 && (part == 3 || part == 4 || part == 6));
                            if (i8) amax_item(KARG(5), NIN, (r & 15) * 64, ((r >> 4) * 8 + wave) * 32, WSP(unsigned, WS_CMAXIN), lane);
                            else tr_item(KARG(5), NIN, (r & 15) * 64, ((r >> 4) * 8 + wave) * 32, WSP(bf16_t, WS_WIN), D, scr, lane, 0, 0); continue; } r -= B_IN;
            if (r < B_GU) { if (P10_I8) amax_item(KARG(16), NGU, (r & 15) * 64, ((r >> 4) * 8 + wave) * 32, WSP(unsigned, WS_CMAXGU), lane);
                            else tr_item(KARG(16), NGU, (r & 15) * 64, ((r >> 4) * 8 + wave) * 32, WSP(bf16_t, WS_WGU), D, scr, lane, 1, 0); continue; } r -= B_GU;
            if (r < B_DN) { tr_item(KARG(17), D, (r % 44) * 64, ((r / 44) * 8 + wave) * 32, WSP(bf16_t, WS_WDN), FF, scr, lane, 2, 0); continue; } r -= B_DN;
            if (r < B_OUT) { tr_item(KARG(14), D, (r & 15) * 64, ((r >> 4) * 8 + wave) * 32, WSP(bf16_t, WS_WOUT), D, scr, lane, 2, 0); continue; } r -= B_OUT;
            { const int sx = r >> 4, h = (r >> 2) & 3, kt = r & 3;
              tr_item((sx ? KARG(11) : KARG(9)) + (size_t)h * 65536, 256, kt * 64, wave * 32, WSP(bf16_t, WS_WRG), 256, scr, lane, 3, h * 2 + sx); }
        }
    }
    if (gridDim.x > 65536u) grid.sync();
    GRID_BAR();
    for (int rep = 0; rep < REP1; ++rep)
    { PHASE_IDS();
      { LAS float* scr = (LAS float*)(lds + wave * 8448);
        constexpr int Q_IN = P2_I8 == 1 ? 16 * (NIN / 256) : (P2_I8 == 2 ? 16 * 12 : 0), Q_GU = P10_I8 ? 16 * (NGU / 256) : 0;
        for (int r0 = bid; r0 < Q_IN + Q_GU; r0 += G) {
            int r = r0;
            if (r < Q_IN) {
                if (P2_I8 == 1) q_item(KARG(5), NIN, (r & 15) * 64, ((r >> 4) * 8 + wave) * 32, WSP(signed char, WS_WIN), D, WSP(unsigned, WS_CMAXIN), WSP(float, WS_SBIN), scr, lane, 0);
                else { const int j = r >> 4, part = (j >> 2) == 0 ? 3 : ((j >> 2) == 1 ? 4 : 6), ng = part * 4 + (j & 3);
                       q_item(KARG(5), NIN, (r & 15) * 64, (ng * 8 + wave) * 32, WSP(signed char, WS_WIN + 8 * MiB), D, WSP(unsigned, WS_CMAXIN), WSP(float, WS_SBIN), scr, lane, 2); }
                continue; }
            r -= Q_IN;
            q_item(KARG(16), NGU, (r & 15) * 64, ((r >> 4) * 8 + wave) * 32, WSP(signed char, WS_WGU), D, WSP(unsigned, WS_CMAXGU), WSP(float, WS_SBGU), scr, lane, 1);
        }
        if (P10_I8 && bid == G - 1 && wave < 4) {
            const float* shp = WSP(float, WS_MOD) + (size_t)wave * NMOD + 3072; float mx = 0.f;
            for (int i = lane; i < D; i += 64) mx = fmaxf(mx, fabsf(shp[i]));
            mx = wave_max(mx); if (lane == 0) WSP(float, WS_SHMAX)[wave] = mx; } }
      if (P2_I8 == 1) norm_rows_i8(KARG(0), KARG(4), WSP(float, WS_MOD), 0, 1024, WSP(signed char, WS_H), WSP(float, WS_SA1), nullptr, gw, NGW, lane);
      else if (P2_I8 == 2) norm_rows_i8(KARG(0), KARG(4), WSP(float, WS_MOD), 0, 1024, (signed char*)OUTP, WSP(float, WS_SA1), WSP(bf16_t, WS_H), gw, NGW, lane);
      else norm_rows_bf16(KARG(0), KARG(4), WSP(float, WS_MOD), 0, 1024, WSP(bf16_t, WS_H), gw, NGW, lane); }
    GRID_BAR();
    for (int rep = 0; rep < REP2; ++rep)
    if (P2_I8 == 1) { pg8::GemmI8 g{WSP(signed char, WS_H), WSP(signed char, WS_WIN), M, NIN, D, D, D}; pg8::StaticOrder S; S.init(M, NIN, G, cid);
      EpiI8<Epi1> E{WSP(float, WS_SA1), WSP(float, WS_SBIN), Epi1{WSP(bf16_t, WS_SA), WSP(bf16_t, WS_P), WSP(bf16_t, WS_G2), WSP(bf16_t, WS_RX)}, 0}; pg8::gemm_phase_i8(lds, g, S, E); }
    else if (P2_I8 == 2) {
      if (CONV3_FUSED) { pg8::Gemm g{WSP(bf16_t, WS_H), WSP(bf16_t, WS_WIN), M, 4096, D, D, D, -1}; pg8::StaticOrder S; S.init(M, 4096, G, cid);
        EpiConvA E{WSP(bf16_t, WS_SA), WSP(bf16_t, WS_P), WSP(bf16_t, WS_P + 1 * MiB), KARG(6)}; pg8::gemm_phase<EpiConvA, true>(lds, g, S, E); }
      else { pg8::Gemm g{WSP(bf16_t, WS_H), WSP(bf16_t, WS_WIN), M, 4096, D, D, D, -1}; pg8::StaticOrder S; S.init(M, 4096, G, cid);
        Epi1 E{WSP(bf16_t, WS_SA), WSP(bf16_t, WS_P), WSP(bf16_t, WS_G2), WSP(bf16_t, WS_RX)}; pg8::gemm_phase(lds, g, S, E); }
      if (CONV4_FUSED) {
        { pg8::GemmI8 g{(const signed char*)OUTP, WSP(signed char, WS_WIN + 8 * MiB), M, 2048, D, D, D}; pg8::StaticOrder S; S.init(M, 2048, G, cid);
          EpiI8<Epi1> E{WSP(float, WS_SA1), WSP(float, WS_SBIN), Epi1{WSP(bf16_t, WS_SA), WSP(bf16_t, WS_P), WSP(bf16_t, WS_G2), WSP(bf16_t, WS_RX)}, 16}; pg8::gemm_phase_i8(lds, g, S, E); }
        { pg8::GemmI8 g{(const signed char*)OUTP, WSP(signed char, WS_WIN + 10 * MiB), M, 1024, D, D, D}; pg8::StaticOrder S; S.init(M, 1024, G, cid);
          EpiConvC E{WSP(float, WS_SA1), WSP(float, WS_SBIN) + 2048, WSP(bf16_t, WS_RX), WSP(bf16_t, WS_P + 2 * MiB), KARG(7), KARG(8)}; pg8::gemm_phase_i8<EpiConvC, true>(lds, g, S, E); } }
      else { pg8::GemmI8 g{(const signed char*)OUTP, WSP(signed char, WS_WIN + 8 * MiB), M, 3072, D, D, D}; pg8::StaticOrder S; S.init(M, 3072, G, cid);
        EpiI8<Epi1> E{WSP(float, WS_SA1), WSP(float, WS_SBIN), Epi1{WSP(bf16_t, WS_SA), WSP(bf16_t, WS_P), WSP(bf16_t, WS_G2), WSP(bf16_t, WS_RX)}, 16}; pg8::gemm_phase_i8(lds, g, S, E); } }
    else { pg8::Gemm g{WSP(bf16_t, WS_H), WSP(bf16_t, WS_WIN), M, NIN, D, D, D, -1}; pg8::StaticOrder S; S.init(M, NIN, G, cid);
      Epi1 E{WSP(bf16_t, WS_SA), WSP(bf16_t, WS_P), WSP(bf16_t, WS_G2), WSP(bf16_t, WS_RX)}; pg8::gemm_phase(lds, g, S, E); }
    GRID_BAR();
    if (CONV4_FUSED && P2_I8 == 2 && SCAN_FUSED && FIX_IN_P4) { }
    else if (CONV4_FUSED && P2_I8 == 2) {
        PHASE_IDS();
        const int gt = bid * 512 + tid;
        if (gt < (M / 128) * 128) {
            const int hb = gt >> 7, c8 = (gt & 127) * 8;
            if (((hb * 128) & (SEQ - 1)) != 0)
                conv_fix_item(hb, c8, true, SCAN_FUSED != 0, KARG(7), KARG(8), KARG(6), WSP(bf16_t, WS_P + 2 * MiB), WSP(bf16_t, WS_RX), WSP(bf16_t, WS_SA), WSP(bf16_t, WS_P), WSP(bf16_t, WS_P + 1 * MiB));
        }
    } else
    for (int rep = 0; rep < REP3; ++rep)
    {
        PHASE_IDS();
        const float* conv_b_w = KARG(7); const float* conv_b_bias = KARG(8); const bf16_t* RX = WSP(bf16_t, WS_RX); bf16_t* U = WSP(bf16_t, WS_H);
        const int c8 = (tid & 127) * 8, tq = tid >> 7;
        float w[4][8], bb[8];
#pragma unroll
        for (int k = 0; k < 4; ++k)
#pragma unroll
            for (int j = 0; j < 8; ++j) w[k][j] = conv_b_w[k * D + c8 + j];
#pragma unroll
        for (int j = 0; j < 8; ++j) bb[j] = conv_b_bias[c8 + j];
        for (int it = bid; it < M / 16; it += G) {
            const int t0 = it * 16 + tq * 4, tb = t0 & (SEQ - 1);
            u32x4 r[7];
#pragma unroll
            for (int i = 0; i < 7; ++i) { r[i] = (u32x4){0u, 0u, 0u, 0u}; if (tb - 3 + i >= 0) r[i] = *(const u32x4*)(RX + (size_t)(t0 - 3 + i) * D + c8); }
#pragma unroll
            for (int o = 0; o < 4; ++o) {
                float v[8];
#pragma unroll
                for (int j = 0; j < 8; ++j) v[j] = bb[j];
#pragma unroll
                for (int k = 0; k < 4; ++k) { const u32x4 q = r[o + k];
                    v[0] += w[k][0] * bf_lo(q.x); v[1] += w[k][1] * bf_hi(q.x); v[2] += w[k][2] * bf_lo(q.y); v[3] += w[k][3] * bf_hi(q.y);
                    v[4] += w[k][4] * bf_lo(q.z); v[5] += w[k][5] * bf_hi(q.z); v[6] += w[k][6] * bf_lo(q.w); v[7] += w[k][7] * bf_hi(q.w); }
                u32x4 wv; wv.x = cvt_pk_bf16(v[0], v[1]); wv.y = cvt_pk_bf16(v[2], v[3]); wv.z = cvt_pk_bf16(v[4], v[5]); wv.w = cvt_pk_bf16(v[6], v[7]);
                *(u32x4*)(U + (size_t)(t0 + o) * D + c8) = wv;
            }
        }
    }
    if (!(CONV4_FUSED && P2_I8 == 2 && SCAN_FUSED && FIX_IN_P4)) GRID_BAR();
    if (SCAN_FUSED) {
      if (FIX_IN_P4) {
        PHASE_IDS();
        pg8::StaticOrder S0; S0.init(M, 2048, G, cid); S0.chain = 1;
        if (tid < 256) {
            const int r = tid >> 6, hh = (tid >> 5) & 1, k = tid & 31; pg8::Unit u0;
            if (S0.next(r, u0)) { const int hb = 2 * u0.pm + hh, c8 = (u0.pn >> 1) * 256 + k * 8;
                if (((hb * 128) & (SEQ - 1)) != 0)
                    conv_fix_item(hb, c8, true, (c8 >> 7) == u0.pn, KARG(7), KARG(8), KARG(6), WSP(bf16_t, WS_P + 2 * MiB), WSP(bf16_t, WS_RX), WSP(bf16_t, WS_SA), WSP(bf16_t, WS_P), WSP(bf16_t, WS_P + 1 * MiB)); }
        }
        asm volatile("s_waitcnt vmcnt(0)" ::: "memory"); __syncthreads();
      }
      pg8::Gemm g{WSP(bf16_t, WS_RX), WSP(bf16_t, WS_WRG), M, 2048, 256, D, 256, 1}; pg8::StaticOrder S; S.init(M, 2048, G, cid); S.chain = 1;
      EpiRG3 E{WSP(bf16_t, WS_RX), WSP(bf16_t, WS_H), WSP(unsigned long long, WS_TOT), WSP(unsigned, WS_FLAG), KARG(10), KARG(12), WSP(float, WS_LS8), (LAS float*)(lds + LDS_XCH),
               WSP(bf16_t, WS_SA), WSP(bf16_t, WS_G2), WSP(bf16_t, WS_P), WSP(bf16_t, WS_P + 1 * MiB), KARG(6)};
      pg8::gemm_phase<EpiRG3, true>(lds, g, S, E); }
    else
    for (int rep = 0; rep < REP4; ++rep)
    { constexpr size_t WS_U = (CONV4_FUSED && P2_I8 == 2) ? WS_RX : WS_H;
      pg8::Gemm g{WSP(bf16_t, WS_U), WSP(bf16_t, WS_WRG), M, 2048, 256, D, 256, 1}; pg8::StaticOrder S; S.init(M, 2048, G, cid);
      EpiRG2 E{WSP(bf16_t, WS_U), WSP(bf16_t, WS_BX), WSP(bf16_t, WS_BX + 64 * MiB), WSP(float, WS_APROD), WSP(float, WS_HEND), KARG(10), KARG(12), WSP(float, WS_LS8), (LAS float*)(lds + LDS_XCH)};
      pg8::gemm_phase<EpiRG2, true>(lds, g, S, E); }
    GRID_BAR();
    if (SCAN_FUSED) {   } else
    if (CONV3_FUSED) {
        PHASE_IDS();
        const float* conv_a_w = KARG(6); const float* AT = WSP(float, WS_APROD); const float* HT = WSP(float, WS_HEND);
        const bf16_t* HL = WSP(bf16_t, WS_BX); const bf16_t* PC = WSP(bf16_t, WS_BX + 64 * MiB);
        const bf16_t* YA = WSP(bf16_t, WS_SA); const bf16_t* PT = WSP(bf16_t, WS_P); const bf16_t* ST = WSP(bf16_t, WS_P + 1 * MiB); const bf16_t* G2 = WSP(bf16_t, WS_G2); bf16_t* MERGED = WSP(bf16_t, WS_RX);
        const int c8 = (tid & 127) * 8, tq = tid >> 7;
        float w0[8], w1[8];
#pragma unroll
        for (int j = 0; j < 8; ++j) { w0[j] = conv_a_w[c8 + j]; w1[j] = conv_a_w[D + c8 + j]; }
        for (int it = bid; it < M / 64; it += G) {
            const int pm = it >> 2, kb = pm & 31;
            float cy[8];
#pragma unroll
            for (int j = 0; j < 8; ++j) cy[j] = 0.f;
#pragma unroll 4
            for (int k = pm - kb; k < pm; ++k) {
                const f32x4 a0 = *(const f32x4*)(AT + (size_t)k * D + c8), a1 = *(const f32x4*)(AT + (size_t)k * D + c8 + 4), h0 = *(const f32x4*)(HT + (size_t)k * D + c8), h1 = *(const f32x4*)(HT + (size_t)k * D + c8 + 4);
#pragma unroll
                for (int j = 0; j < 4; ++j) { cy[j] = a0[j] * cy[j] + h0[j]; cy[4 + j] = a1[j] * cy[4 + j] + h1[j]; }
            }
            const int t0 = it * 64 + tq * 16;
            float fx0[8], fx1[8];
#pragma unroll
            for (int j = 0; j < 8; ++j) { fx0[j] = 0.f; fx1[j] = 0.f; }
            if ((t0 & 127) == 0 && (t0 & (SEQ - 1)) != 0) {
                const int hb = t0 >> 7;
                const u32x4 s0 = *(const u32x4*)(ST + (size_t)(hb * 2 + 0) * D + c8), s1 = *(const u32x4*)(ST + (size_t)(hb * 2 + 1) * D + c8);
                const u32x4 pa = *(const u32x4*)(PT + (size_t)((hb - 1) * 2 + 0) * D + c8), pb = *(const u32x4*)(PT + (size_t)((hb - 1) * 2 + 1) * D + c8);
                const unsigned s0w[4] = {s0.x, s0.y, s0.z, s0.w}, s1w[4] = {s1.x, s1.y, s1.z, s1.w}, paw[4] = {pa.x, pa.y, pa.z, pa.w}, pbw[4] = {pb.x, pb.y, pb.z, pb.w};
#pragma unroll
                for (int q = 0; q < 4; ++q) {
                    const int j0 = 2 * q, j1 = 2 * q + 1;
                    fx0[j0] = bf_lo(s0w[q]) * (w0[j0] * bf_lo(paw[q]) + w1[j0] * bf_lo(pbw[q])); fx0[j1] = bf_hi(s0w[q]) * (w0[j1] * bf_hi(paw[q]) + w1[j1] * bf_hi(pbw[q]));
                    fx1[j0] = bf_lo(s1w[q]) * (w0[j0] * bf_lo(pbw[q]));                            fx1[j1] = bf_hi(s1w[q]) * (w0[j1] * bf_hi(pbw[q]));
                }
            }
            for (int tb = 0; tb < 16; tb += 4) {
                u32x4 qh[4], qc[4], qy[4], qg[4];
#pragma unroll
                for (int t = 0; t < 4; ++t) { const unsigned o = ((unsigned)(t0 + tb + t) * D + c8) * 2u; qh[t] = *(const u32x4*)((const char*)HL + o); qc[t] = *(const u32x4*)((const char*)PC + o); qy[t] = *(const u32x4*)((const char*)YA + o); qg[t] = *(const u32x4*)((const char*)G2 + o); }
#pragma unroll
                for (int t = 0; t < 4; ++t) {
                    const unsigned hw[4] = {qh[t].x, qh[t].y, qh[t].z, qh[t].w}, cw[4] = {qc[t].x, qc[t].y, qc[t].z, qc[t].w}, yw[4] = {qy[t].x, qy[t].y, qy[t].z, qy[t].w}, gw4[4] = {qg[t].x, qg[t].y, qg[t].z, qg[t].w};
                    unsigned ow[4];
#pragma unroll
                    for (int q = 0; q < 4; ++q) {
                        const int j0 = 2 * q, j1 = 2 * q + 1;
                        const float h0 = bf_lo(hw[q]) + bf_lo(cw[q]) * cy[j0], h1 = bf_hi(hw[q]) + bf_hi(cw[q]) * cy[j1];
                        float m0 = bf_lo(yw[q]) + h0 * bf_lo(gw4[q]), m1 = bf_hi(yw[q]) + h1 * bf_hi(gw4[q]);
                        if (tb == 0 && t == 0) { m0 += fx0[j0]; m1 += fx0[j1]; }
                        if (tb == 0 && t == 1) { m0 += fx1[j0]; m1 += fx1[j1]; }
                        ow[q] = cvt_pk_bf16(m0, m1);
                    }
                    *(u32x4*)((char*)MERGED + ((unsigned)(t0 + tb + t) * D + c8) * 2u) = (u32x4){ow[0], ow[1], ow[2], ow[3]};
                }
            }
        }
    } else
    for (int rep = 0; rep < REP7; ++rep)
    {
        PHASE_IDS();
        const float* conv_a_w = KARG(6); const float* AT = WSP(float, WS_APROD); const float* HT = WSP(float, WS_HEND);
        const bf16_t* HL = WSP(bf16_t, WS_BX); const bf16_t* PC = WSP(bf16_t, WS_BX + 64 * MiB);
        const bf16_t* PP = WSP(bf16_t, WS_P); const bf16_t* SA = WSP(bf16_t, WS_SA); const bf16_t* G2 = WSP(bf16_t, WS_G2); bf16_t* MERGED = WSP(bf16_t, WS_RX);
        const int c8 = (tid & 127) * 8, tq = tid >> 7;
        float w0[8], w1[8], w2[8];
#pragma unroll
        for (int j = 0; j < 8; ++j) { w0[j] = conv_a_w[c8 + j]; w1[j] = conv_a_w[D + c8 + j]; w2[j] = conv_a_w[2 * D + c8 + j]; }
        for (int it = bid; it < M / 64; it += G) {
            const int pm = it >> 2, kb = pm & 31;
            float cy[8];
#pragma unroll
            for (int j = 0; j < 8; ++j) cy[j] = 0.f;
#pragma unroll 4
            for (int k = pm - kb; k < pm; ++k) {
                const f32x4 a0 = *(const f32x4*)(AT + (size_t)k * D + c8), a1 = *(const f32x4*)(AT + (size_t)k * D + c8 + 4), h0 = *(const f32x4*)(HT + (size_t)k * D + c8), h1 = *(const f32x4*)(HT + (size_t)k * D + c8 + 4);
#pragma unroll
                for (int j = 0; j < 4; ++j) { cy[j] = a0[j] * cy[j] + h0[j]; cy[4 + j] = a1[j] * cy[4 + j] + h1[j]; }
            }
            const int t0 = it * 64 + tq * 16;
            float pm2[8], pm1[8];
            {
                u32x4 q2 = {0u, 0u, 0u, 0u}, q1 = {0u, 0u, 0u, 0u};
                if ((t0 & (SEQ - 1)) != 0) { q2 = *(const u32x4*)(PP + (size_t)(t0 - 2) * D + c8); q1 = *(const u32x4*)(PP + (size_t)(t0 - 1) * D + c8); }
                pm2[0] = bf_lo(q2.x); pm2[1] = bf_hi(q2.x); pm2[2] = bf_lo(q2.y); pm2[3] = bf_hi(q2.y); pm2[4] = bf_lo(q2.z); pm2[5] = bf_hi(q2.z); pm2[6] = bf_lo(q2.w); pm2[7] = bf_hi(q2.w);
                pm1[0] = bf_lo(q1.x); pm1[1] = bf_hi(q1.x); pm1[2] = bf_lo(q1.y); pm1[3] = bf_hi(q1.y); pm1[4] = bf_lo(q1.z); pm1[5] = bf_hi(q1.z); pm1[6] = bf_lo(q1.w); pm1[7] = bf_hi(q1.w);
            }
            for (int tb = 0; tb < 16; tb += 4) {
                u32x4 qh[4], qc[4], qp[4], qs[4], qg[4];
#pragma unroll
                for (int t = 0; t < 4; ++t) { const unsigned o = ((unsigned)(t0 + tb + t) * D + c8) * 2u; qh[t] = *(const u32x4*)((const char*)HL + o); qc[t] = *(const u32x4*)((const char*)PC + o); qp[t] = *(const u32x4*)((const char*)PP + o); qs[t] = *(const u32x4*)((const char*)SA + o); qg[t] = *(const u32x4*)((const char*)G2 + o); }
#pragma unroll
                for (int t = 0; t < 4; ++t) {
                    const unsigned hw[4] = {qh[t].x, qh[t].y, qh[t].z, qh[t].w}, cw[4] = {qc[t].x, qc[t].y, qc[t].z, qc[t].w}, pw[4] = {qp[t].x, qp[t].y, qp[t].z, qp[t].w},
                                   sw[4] = {qs[t].x, qs[t].y, qs[t].z, qs[t].w}, gw4[4] = {qg[t].x, qg[t].y, qg[t].z, qg[t].w};
                    unsigned ow[4];
#pragma unroll
                    for (int q = 0; q < 4; ++q) {
                        const int j0 = 2 * q, j1 = 2 * q + 1;
                        const float pc0 = bf_lo(pw[q]), pc1 = bf_hi(pw[q]);
                        const float h0 = bf_lo(hw[q]) + bf_lo(cw[q]) * cy[j0], h1 = bf_hi(hw[q]) + bf_hi(cw[q]) * cy[j1];
                        const float m0 = bf_lo(sw[q]) * (w0[j0] * pm2[j0] + w1[j0] * pm1[j0] + w2[j0] * pc0) + h0 * bf_lo(gw4[q]);
                        const float m1 = bf_hi(sw[q]) * (w0[j1] * pm2[j1] + w1[j1] * pm1[j1] + w2[j1] * pc1) + h1 * bf_hi(gw4[q]);
                        ow[q] = cvt_pk_bf16(m0, m1);
                        pm2[j0] = pm1[j0]; pm1[j0] = pc0; pm2[j1] = pm1[j1]; pm1[j1] = pc1;
                    }
                    *(u32x4*)((char*)MERGED + ((unsigned)(t0 + tb + t) * D + c8) * 2u) = (u32x4){ow[0], ow[1], ow[2], ow[3]};
                }
            }
        }
    }
    if (!SCAN_FUSED) GRID_BAR();
    for (int rep = 0; rep < REP8; ++rep)
    { pg8::Gemm g{SCAN_FUSED ? WSP(bf16_t, WS_H) : WSP(bf16_t, WS_RX), WSP(bf16_t, WS_WOUT), M, D, D, D, D, -1}; pg8::StaticOrder S; S.init(M, D, G, cid);
      EpiResNorm<0, P10_I8 != 0> E{KARG(0), WSP(bf16_t, WS_BX), WSP(float, WS_MOD) + 2048, WSP(float, WS_RSS1), WSP(unsigned, WS_CNT1), KARG(15), WSP(float, WS_MOD), SCAN_FUSED ? (bf16_t*)OUTP : WSP(bf16_t, WS_H), WSP(unsigned, WS_RMX), WSP(float, WS_SA2), WSP(float, WS_SHMAX)}; pg8::gemm_phase(lds, g, S, E); }
    GRID_BAR();
    for (int rep = 0; rep < REP10; ++rep)
    if (P10_I8) { pg8::GemmI8 g{SCAN_FUSED ? (const signed char*)OUTP : WSP(signed char, WS_H), WSP(signed char, WS_WGU), M, NGU, D, D, D}; pg8::StaticOrder S; S.init(M, NGU, G, cid);
      EpiI8<EpiGU> E{WSP(float, WS_SA2), WSP(float, WS_SBGU), EpiGU{WSP(bf16_t, WS_ACT)}, 0}; pg8::gemm_phase_i8(lds, g, S, E); }
    else { pg8::Gemm g{WSP(bf16_t, WS_H), WSP(bf16_t, WS_WGU), M, NGU, D, D, D, -1}; pg8::StaticOrder S; S.init(M, NGU, G, cid); EpiGU E{WSP(bf16_t, WS_ACT)}; pg8::gemm_phase(lds, g, S, E); }
    GRID_BAR();
    for (int rep = 0; rep < REP11; ++rep)
    { pg8::Gemm g{WSP(bf16_t, WS_ACT), WSP(bf16_t, WS_WDN), M, D, FF, FF, FF, -1}; pg8::StaticOrder S; S.init(M, D, G, cid);
      EpiResNorm<1> E{WSP(bf16_t, WS_BX), OUTP, WSP(float, WS_MOD) + 5120, WSP(float, WS_RSS2), WSP(unsigned, WS_CNT2), KARG(18), nullptr, nullptr, nullptr, nullptr, nullptr}; pg8::gemm_phase(lds, g, S, E); }
    if (pass + 1 < NPASS) GRID_BAR();
    }
}

extern "C" void kernel_launch(void* const* d_in, const int* in_sizes, int n_in, void* d_out, int out_size, void* d_ws, size_t ws_size, hipStream_t stream) {
    static int grid_blocks = 0;
    if (grid_blocks == 0) {
        if (n_in != 19 || out_size != M * D || ws_size < WS_END) { fprintf(stderr, "kernel_launch: unexpected shapes (n_in %d out %d ws %zu)\n", n_in, out_size, ws_size); grid_blocks = -1; return; }
        int dev = 0, cus = 0, per_cu = 0;
        hipGetDevice(&dev);
        hipDeviceGetAttribute(&cus, hipDeviceAttributeMultiprocessorCount, dev);
        hipFuncSetAttribute((const void*)fwd_megakernel, hipFuncAttributeMaxDynamicSharedMemorySize, LDS_BYTES);
        hipOccupancyMaxActiveBlocksPerMultiprocessor(&per_cu, (const void*)fwd_megakernel, 512, LDS_BYTES);
        if (per_cu < 1) { fprintf(stderr, "kernel_launch: occupancy query says %d blocks per CU\n", per_cu); grid_blocks = -1; return; }
        if (SCAN_FUSED && cus != 256) { fprintf(stderr, "kernel_launch: the chain-ordered scan phase is laid out for 256 CUs, this device has %d\n", cus); grid_blocks = -1; return; }
        grid_blocks = cus;
    }
    if (grid_blocks < 0) return;
    if (hipMemsetAsync((char*)d_ws + WS_BAR, 0, (WS_CTL_END - WS_BAR), stream) != hipSuccess) { fprintf(stderr, "kernel_launch: memset of the barrier words failed\n"); return; }
    Params p{};
    for (int i = 0; i < 19; ++i) p.in[i] = (const float*)d_in[i];
    p.out = (float*)d_out; p.ws = (unsigned char*)d_ws;
    void* args[] = {&p};
    hipError_t e = hipLaunchCooperativeKernel((const void*)fwd_megakernel, dim3(grid_blocks), dim3(512), args, LDS_BYTES, stream);
    if (e != hipSuccess) fprintf(stderr, "cooperative launch failed: %s (grid %d)\n", hipGetErrorString(e), grid_blocks);
}
```

```cpp
#include <hip/hip_runtime.h>
#include <hip/hip_cooperative_groups.h>
#include <cstdio>
namespace cg = cooperative_groups;

#define LAS __attribute__((address_space(3)))
typedef unsigned short bf16_t;
typedef short bf16x8 __attribute__((ext_vector_type(8)));
typedef float f32x4 __attribute__((ext_vector_type(4)));
typedef float f32x2 __attribute__((ext_vector_type(2)));
typedef unsigned u32x4 __attribute__((ext_vector_type(4)));
typedef unsigned u32x2 __attribute__((ext_vector_type(2)));
typedef int i32x4 __attribute__((ext_vector_type(4)));

constexpr int M = 32768, D = 1024, SEQ = 8192, FF = 2816, NIN = 7168, NGU = 5632, NMOD = 6144;
constexpr float EPS = 1e-6f;
constexpr size_t MiB = (size_t)1 << 20;
constexpr size_t WS_MOD = 0, WS_LS8 = 128 * 1024, WS_APROD = 1 * MiB, WS_HEND = 3 * MiB, WS_CIN = 5 * MiB;
constexpr size_t WS_WIN = 8 * MiB, WS_WGU = 22 * MiB, WS_WDN = 33 * MiB, WS_WOUT = 39 * MiB, WS_WRG = 41 * MiB;
constexpr size_t WS_H = 48 * MiB, WS_SA = 112 * MiB, WS_P = 176 * MiB, WS_G2 = 240 * MiB, WS_RX = 304 * MiB, WS_BX = 368 * MiB, WS_END = 496 * MiB;
constexpr size_t WS_ACT = 112 * MiB;
constexpr int LDS_XCH = 131072 + 16;
constexpr int LDS_BYTES = 131072 + 16 + 1024;
constexpr size_t WS_BAR = 256 * 1024;
constexpr size_t WS_RSS1 = 272 * 1024, WS_RSS2 = 400 * 1024;
constexpr size_t WS_CNT1 = 528 * 1024, WS_CNT2 = 592 * 1024;
constexpr size_t WS_CMAXIN = 656 * 1024, WS_CMAXGU = 688 * 1024;
constexpr size_t WS_RMX = 720 * 1024, WS_FLAG = 848 * 1024, WS_CTL_END = 852 * 1024;
constexpr size_t WS_TOT = 1 * MiB;
constexpr size_t WS_SA1 = 5 * MiB, WS_SA2 = WS_SA1 + 128 * 1024, WS_SBIN = WS_SA2 + 128 * 1024, WS_SBGU = WS_SBIN + 32 * 1024, WS_SHMAX = WS_SBGU + 32 * 1024;
#ifndef P2_I8
#define P2_I8 2
#endif
#ifndef P10_I8
#define P10_I8 1
#endif
#ifndef FIX_IN_P4
#define FIX_IN_P4 1
#endif
#ifndef SCAN_FUSED
#define SCAN_FUSED 1
#endif
#ifndef CONV4_FUSED
#define CONV4_FUSED 1
#endif
#ifndef CONV3_FUSED
#define CONV3_FUSED 1
#endif
#ifndef KREP2
#define KREP2 1
#endif
#ifndef EREPX
#define EREPX 1
#endif
#ifndef NPASS
#define NPASS 1
#endif
#ifndef REP1
#define REP1 1
#endif
#ifndef REP3
#define REP3 1
#endif
#ifndef REP7
#define REP7 1
#endif
#ifndef REP0
#define REP0 1
#endif
#ifndef REP2
#define REP2 1
#endif
#ifndef REP4
#define REP4 1
#endif
#ifndef REP8
#define REP8 1
#endif
#ifndef REP10
#define REP10 1
#endif
#ifndef REP11
#define REP11 1
#endif

namespace pg8 {
constexpr int BM = 256, BK = 64, HALF = 128, HTB = HALF * BK * 2, STAGE_BYTES = 8 * HTB, NXCD = 8, WGM = 4;
__host__ __device__ __forceinline__ int lds_byte(int r, int c) { const int st = (r >> 4) * 2 + (c >> 5), rr = r & 15, cc = c & 31, ob = rr * 64 + cc * 2; return st * 1024 + (ob ^ (((ob >> 9) & 1) << 5)); }
__host__ __device__ __forceinline__ void stage_rc(int b, int& R, int& C) { const int st = b / 1024, sb = b % 1024, swz = sb ^ (((sb >> 9) & 1) << 5); R = (st >> 1) * 16 + swz / 64; C = (st & 1) * 32 + (swz % 64) / 2; }
struct Unit { int pm, pn; };
struct Gemm { const bf16_t* A; const bf16_t* Bt; int M, N, K, lda, ldb, a_pn_shift; };
struct StaticOrder {
    int nM, nN, nwg, G, c, chain;
    __host__ __device__ void init(int M_, int N_, int G_, int c_) { nM = M_ / BM; nN = N_ / BM; nwg = nM * nN; G = G_; c = c_; chain = 0; }
    __host__ __device__ bool next(int i, Unit& u) const {
        if (chain) { if (i >= 4) return false; const int x = c & 7, j = c >> 3; u.pm = 32 * (x >> 1) + 8 * i + (x & 1) * 4 + (j >> 3); u.pn = j & 7; return true; }
        const long L = (long)i * G + c; if (L >= nwg) return false;
        int wgid = (int)L; { const int q = nwg / NXCD, r = nwg % NXCD, xcd = wgid % NXCD, off = wgid / NXCD; wgid = (xcd < r ? xcd * (q + 1) : r * (q + 1) + (xcd - r) * q) + off; }
        const int nig = WGM * nN, gid = wgid / nig, fm = gid * WGM, gsz = (nM - fm) < WGM ? (nM - fm) : WGM;
        u.pm = fm + ((wgid % nig) % gsz); u.pn = (wgid % nig) / gsz; return true;
    }
};
__device__ __forceinline__ unsigned cvt_pk_bf16(float lo, float hi) { unsigned r; asm volatile("v_cvt_pk_bf16_f32 %0, %1, %2" : "=v"(r) : "v"(lo), "v"(hi)); return r; }

template <class Epi, bool APERM = false, int KREP = 1, int EREP = 1>
__device__ __forceinline__ void gemm_phase(LAS unsigned char* lds, const Gemm g, const StaticOrder& S, const Epi& E) {
    int tid = threadIdx.x; asm volatile("" : "+v"(tid));
    const int wid = __builtin_amdgcn_readfirstlane(tid >> 6), lane = tid & 63, wr = wid >> 2, wc = wid & 3, fr = lane & 15, fq = lane >> 4;
    int K = g.K; asm volatile("" : "+s"(K)); const int nt = K / BK;
    unsigned voffA[2], voffB[2];
#pragma unroll
    for (int i = 0; i < 2; ++i) { int R, C; stage_rc(tid * 16 + i * 8192, R, C); const int Ra = APERM ? (8 * ((R & 15) + 16 * (R >> 6)) + ((R >> 4) & 3)) : R; voffA[i] = (unsigned)(Ra * g.lda + C) * 2u; voffB[i] = (unsigned)(R * g.ldb + C) * 2u; }
    const size_t kstep = (size_t)(BK * 2);
    const size_t hstepA = (size_t)(APERM ? 4 : HALF) * g.lda * 2, hstepB = (size_t)HALF * g.ldb * 2;
    const size_t tstepA = (size_t)BM * g.lda * 2, tstepB = 2 * hstepB;
    const unsigned ldsw = (unsigned)wid * 1024u;
    const int aoff = lds_byte(wr * 64 + fr, fq * 8), boff = lds_byte(wc * 32 + fr, fq * 8);
#define PG8_SA(b, h) (((b) * 2 + (h)) * HTB)
#define PG8_SB(b, h) ((4 + (b) * 2 + (h)) * HTB)
#define PG8_STAGE(bufoff, gbase, voff) do { _Pragma("unroll") for (int _i = 0; _i < 2; ++_i) \
        __builtin_amdgcn_global_load_lds((const unsigned*)((const char*)(gbase) + (voff)[_i]), (LAS unsigned*)(lds + (bufoff) + ldsw + _i * 8192), 16, 0, 0); } while (0)
#define PG8_LDA(dst, b, h) do { _Pragma("unroll") for (int m = 0; m < 4; ++m) _Pragma("unroll") for (int k = 0; k < 2; ++k) dst[m][k] = *(const LAS bf16x8*)(lds + PG8_SA(b, h) + aoff + m * 2048 + k * 1024); } while (0)
#define PG8_LDB(dst, b, h) do { _Pragma("unroll") for (int n = 0; n < 2; ++n) _Pragma("unroll") for (int k = 0; k < 2; ++k) dst[n][k] = *(const LAS bf16x8*)(lds + PG8_SB(b, h) + boff + n * 2048 + k * 1024); } while (0)
#define PG8_MMA(ai, bj, At, Bt) do { __builtin_amdgcn_s_setprio(1); _Pragma("unroll") for (int m = 0; m < 4; ++m) _Pragma("unroll") for (int n = 0; n < 2; ++n) _Pragma("unroll") for (int k = 0; k < 2; ++k) \
        acc[ai][bj][m][n] = __builtin_amdgcn_mfma_f32_16x16x32_bf16(Bt[n][k], At[m][k], acc[ai][bj][m][n], 0, 0, 0); __builtin_amdgcn_s_setprio(0); } while (0)
#define PG8_WAIT_V(n) asm volatile("s_waitcnt vmcnt(" #n ")" ::: "memory")
#define PG8_WAIT_L(n) asm volatile("s_waitcnt lgkmcnt(" #n ")" ::: "memory")
#define PG8_BAR __builtin_amdgcn_s_barrier()
#define PG8_SCHED __builtin_amdgcn_sched_barrier(0)
#define PG8_APTR(u) ((const char*)g.A + (size_t)(u).pm * tstepA + (g.a_pn_shift >= 0 ? (size_t)((u).pn >> g.a_pn_shift) * (size_t)K * 2 : (size_t)0))
#define PG8_BPTR(u) ((const char*)g.Bt + (size_t)(u).pn * tstepB)
    Unit cur, nxt; int ui = 0;
    if (!S.next(0, cur)) return;
    f32x4 acc[2][2][4][2];
#pragma unroll
    for (int a = 0; a < 2; ++a)
#pragma unroll
        for (int b = 0; b < 2; ++b)
#pragma unroll
            for (int m = 0; m < 4; ++m)
#pragma unroll
                for (int n = 0; n < 2; ++n) acc[a][b][m][n] = (f32x4){0.f, 0.f, 0.f, 0.f};
    bf16x8 At[4][2], B0[2][2], B1[2][2];
    const char* cA = PG8_APTR(cur); const char* cB = PG8_BPTR(cur);
    PG8_STAGE(PG8_SB(0, 0), cB, voffB); PG8_STAGE(PG8_SA(0, 0), cA, voffA); PG8_STAGE(PG8_SB(0, 1), cB + hstepB, voffB); PG8_STAGE(PG8_SA(0, 1), cA + hstepA, voffA);
    if (wr == 1) PG8_BAR;
    PG8_WAIT_V(4); PG8_BAR;
    PG8_STAGE(PG8_SB(1, 0), cB + kstep, voffB); PG8_STAGE(PG8_SA(1, 0), cA + kstep, voffA); PG8_STAGE(PG8_SB(1, 1), cB + hstepB + kstep, voffB);
    PG8_WAIT_V(6); PG8_BAR;
    for (;;) {
        const bool has_next = S.next((ui + 1) / KREP, nxt);
        const char* nA = has_next ? PG8_APTR(nxt) : cA; const char* nB = has_next ? PG8_BPTR(nxt) : cB;
#pragma unroll 1
        for (int t = 0; t < nt; t += 2) {
            const bool last = (t == nt - 2);
            const char* a1 = cA + (size_t)(t + 1) * kstep;
            const char* a2 = last ? nA : cA + (size_t)(t + 2) * kstep; const char* b2 = last ? nB : cB + (size_t)(t + 2) * kstep;
            const char* a3 = a2 + kstep; const char* b3 = b2 + kstep;
            PG8_LDB(B0, 0, 0); PG8_SCHED; PG8_LDA(At, 0, 0); PG8_STAGE(PG8_SA(1, 1), a1 + hstepA, voffA);
            PG8_WAIT_L(8); PG8_BAR; PG8_WAIT_L(0); PG8_MMA(0, 0, At, B0); PG8_BAR; PG8_SCHED;
            PG8_LDB(B1, 0, 1); PG8_STAGE(PG8_SB(0, 0), b2, voffB);
            PG8_BAR; PG8_WAIT_L(0); PG8_MMA(0, 1, At, B1); PG8_BAR;
            PG8_LDA(At, 0, 1); PG8_STAGE(PG8_SA(0, 0), a2, voffA);
            PG8_BAR; PG8_WAIT_L(0); PG8_MMA(1, 0, At, B0); PG8_BAR; PG8_SCHED;
            PG8_STAGE(PG8_SB(0, 1), b2 + hstepB, voffB);
            PG8_WAIT_V(6); PG8_BAR; PG8_MMA(1, 1, At, B1); PG8_BAR;
            PG8_LDB(B0, 1, 0); PG8_SCHED; PG8_LDA(At, 1, 0); PG8_STAGE(PG8_SA(0, 1), a2 + hstepA, voffA);
            PG8_WAIT_L(8); PG8_BAR; PG8_WAIT_L(0); PG8_MMA(0, 0, At, B0); PG8_BAR; PG8_SCHED;
            PG8_LDB(B1, 1, 1); PG8_STAGE(PG8_SB(1, 0), b3, voffB);
            PG8_BAR; PG8_WAIT_L(0); PG8_MMA(0, 1, At, B1); PG8_BAR;
            PG8_LDA(At, 1, 1); PG8_STAGE(PG8_SA(1, 0), a3, voffA);
            PG8_BAR; PG8_WAIT_L(0); PG8_MMA(1, 0, At, B0); PG8_BAR; PG8_SCHED;
            PG8_STAGE(PG8_SB(1, 1), b3 + hstepB, voffB);
            PG8_WAIT_V(6); PG8_BAR; PG8_MMA(1, 1, At, B1); PG8_BAR;
        }
        if ((ui % KREP) == KREP - 1) {
        if (wr == 0) PG8_BAR;
        E(acc, cur, wr, wc, fr, fq);
        if (EREP > 1) {
_Pragma("unroll") for (int a = 0; a < 2; ++a) _Pragma("unroll") for (int b = 0; b < 2; ++b) _Pragma("unroll") for (int m = 0; m < 4; ++m) _Pragma("unroll") for (int n = 0; n < 2; ++n) asm volatile("" : "+v"(acc[a][b][m][n]));
            E(acc, cur, wr, wc, fr, fq); }
        if (wr == 1) PG8_BAR;
        }
        if (!has_next) break;
#pragma unroll
        for (int a = 0; a < 2; ++a)
#pragma unroll
            for (int b = 0; b < 2; ++b)
#pragma unroll
                for (int m = 0; m < 4; ++m)
#pragma unroll
                    for (int n = 0; n < 2; ++n) acc[a][b][m][n] = (f32x4){0.f, 0.f, 0.f, 0.f};
        cur = nxt; cA = nA; cB = nB; ++ui;
    }
    PG8_WAIT_V(0);
    if (wr == 0) PG8_BAR;
    PG8_BAR;
#undef PG8_SA
#undef PG8_SB
#undef PG8_STAGE
#undef PG8_LDA
#undef PG8_LDB
#undef PG8_MMA
#undef PG8_WAIT_V
#undef PG8_WAIT_L
#undef PG8_BAR
#undef PG8_SCHED
#undef PG8_APTR
#undef PG8_BPTR
}

struct GemmI8 { const signed char* A; const signed char* Bt; int M, N, K, lda, ldb; };
template <class Epi, bool APERM = false>
__device__ __forceinline__ void gemm_phase_i8(LAS unsigned char* lds, const GemmI8 g, const StaticOrder& S, const Epi& E) {
    int tid = threadIdx.x; asm volatile("" : "+v"(tid));
    const int wid = __builtin_amdgcn_readfirstlane(tid >> 6), lane = tid & 63, wr = wid >> 2, wc = wid & 3, fr = lane & 15, fq = lane >> 4;
    int K = g.K; asm volatile("" : "+s"(K)); const int nt = K / 128;
    unsigned voffA[2], voffB[2];
#pragma unroll
    for (int i = 0; i < 2; ++i) { int R, C; stage_rc(tid * 16 + i * 8192, R, C); const int Ra = APERM ? (8 * ((R & 15) + 16 * (R >> 6)) + ((R >> 4) & 3)) : R; voffA[i] = (unsigned)(Ra * g.lda + 2 * C); voffB[i] = (unsigned)(R * g.ldb + 2 * C); }
    const size_t kstep = (size_t)(BK * 2);
    const size_t hstepA = (size_t)(APERM ? 4 : HALF) * g.lda, hstepB = (size_t)HALF * g.ldb;
    const size_t tstepA = (size_t)BM * g.lda, tstepB = 2 * hstepB;
    const unsigned ldsw = (unsigned)wid * 1024u;
    const int aoff = lds_byte(wr * 64 + fr, fq * 8), boff = lds_byte(wc * 32 + fr, fq * 8);
#define PG8_SA(b, h) (((b) * 2 + (h)) * HTB)
#define PG8_SB(b, h) ((4 + (b) * 2 + (h)) * HTB)
#define PG8_STAGE(bufoff, gbase, voff) do { _Pragma("unroll") for (int _i = 0; _i < 2; ++_i) \
        __builtin_amdgcn_global_load_lds((const unsigned*)((const char*)(gbase) + (voff)[_i]), (LAS unsigned*)(lds + (bufoff) + ldsw + _i * 8192), 16, 0, 0); } while (0)
#define PG8_LDA(dst, b, h) do { _Pragma("unroll") for (int m = 0; m < 4; ++m) _Pragma("unroll") for (int k = 0; k < 2; ++k) dst[m][k] = *(const LAS bf16x8*)(lds + PG8_SA(b, h) + aoff + m * 2048 + k * 1024); } while (0)
#define PG8_LDB(dst, b, h) do { _Pragma("unroll") for (int n = 0; n < 2; ++n) _Pragma("unroll") for (int k = 0; k < 2; ++k) dst[n][k] = *(const LAS bf16x8*)(lds + PG8_SB(b, h) + boff + n * 2048 + k * 1024); } while (0)
#define PG8_MMA(ai, bj, At, Bt) do { __builtin_amdgcn_s_setprio(1); _Pragma("unroll") for (int m = 0; m < 4; ++m) _Pragma("unroll") for (int n = 0; n < 2; ++n) _Pragma("unroll") for (int k = 0; k < 2; ++k) \
        acc[ai][bj][m][n] = __builtin_amdgcn_mfma_i32_16x16x64_i8(__builtin_bit_cast(i32x4, Bt[n][k]), __builtin_bit_cast(i32x4, At[m][k]), acc[ai][bj][m][n], 0, 0, 0); __builtin_amdgcn_s_setprio(0); } while (0)
#define PG8_WAIT_V(n) asm volatile("s_waitcnt vmcnt(" #n ")" ::: "memory")
#define PG8_WAIT_L(n) asm volatile("s_waitcnt lgkmcnt(" #n ")" ::: "memory")
#define PG8_BAR __builtin_amdgcn_s_barrier()
#define PG8_SCHED __builtin_amdgcn_sched_barrier(0)
#define PG8_APTR(u) ((const char*)g.A + (size_t)(u).pm * tstepA)
#define PG8_BPTR(u) ((const char*)g.Bt + (size_t)(u).pn * tstepB)
    Unit cur, nxt; int ui = 0;
    if (!S.next(0, cur)) return;
    i32x4 acc[2][2][4][2];
#pragma unroll
    for (int a = 0; a < 2; ++a)
#pragma unroll
        for (int b = 0; b < 2; ++b)
#pragma unroll
            for (int m = 0; m < 4; ++m)
#pragma unroll
                for (int n = 0; n < 2; ++n) acc[a][b][m][n] = (i32x4){0, 0, 0, 0};
    bf16x8 At[4][2], B0[2][2], B1[2][2];
    const char* cA = PG8_APTR(cur); const char* cB = PG8_BPTR(cur);
    PG8_STAGE(PG8_SB(0, 0), cB, voffB); PG8_STAGE(PG8_SA(0, 0), cA, voffA); PG8_STAGE(PG8_SB(0, 1), cB + hstepB, voffB); PG8_STAGE(PG8_SA(0, 1), cA + hstepA, voffA);
    if (wr == 1) PG8_BAR;
    PG8_WAIT_V(4); PG8_BAR;
    PG8_STAGE(PG8_SB(1, 0), cB + kstep, voffB); PG8_STAGE(PG8_SA(1, 0), cA + kstep, voffA); PG8_STAGE(PG8_SB(1, 1), cB + hstepB + kstep, voffB);
    PG8_WAIT_V(6); PG8_BAR;
    for (;;) {
        const bool has_next = S.next(ui + 1, nxt);
        const char* nA = has_next ? PG8_APTR(nxt) : cA; const char* nB = has_next ? PG8_BPTR(nxt) : cB;
#pragma unroll 1
        for (int t = 0; t < nt; t += 2) {
            const bool last = (t == nt - 2);
            const char* a1 = cA + (size_t)(t + 1) * kstep;
            const char* a2 = last ? nA : cA + (size_t)(t + 2) * kstep; const char* b2 = last ? nB : cB + (size_t)(t + 2) * kstep;
            const char* a3 = a2 + kstep; const char* b3 = b2 + kstep;
            PG8_LDB(B0, 0, 0); PG8_SCHED; PG8_LDA(At, 0, 0); PG8_STAGE(PG8_SA(1, 1), a1 + hstepA, voffA);
            PG8_WAIT_L(8); PG8_BAR; PG8_WAIT_L(0); PG8_MMA(0, 0, At, B0); PG8_BAR; PG8_SCHED;
            PG8_LDB(B1, 0, 1); PG8_STAGE(PG8_SB(0, 0), b2, voffB);
            PG8_BAR; PG8_WAIT_L(0); PG8_MMA(0, 1, At, B1); PG8_BAR;
            PG8_LDA(At, 0, 1); PG8_STAGE(PG8_SA(0, 0), a2, voffA);
            PG8_BAR; PG8_WAIT_L(0); PG8_MMA(1, 0, At, B0); PG8_BAR; PG8_SCHED;
            PG8_STAGE(PG8_SB(0, 1), b2 + hstepB, voffB);
            PG8_WAIT_V(6); PG8_BAR; PG8_MMA(1, 1, At, B1); PG8_BAR;
            PG8_LDB(B0, 1, 0); PG8_SCHED; PG8_LDA(At, 1, 0); PG8_STAGE(PG8_SA(0, 1), a2 + hstepA, voffA);
            PG8_WAIT_L(8); PG8_BAR; PG8_WAIT_L(0); PG8_MMA(0, 0, At, B0); PG8_BAR; PG8_SCHED;
            PG8_LDB(B1, 1, 1); PG8_STAGE(PG8_SB(1, 0), b3, voffB);
            PG8_BAR; PG8_WAIT_L(0); PG8_MMA(0, 1, At, B1); PG8_BAR;
            PG8_LDA(At, 1, 1); PG8_STAGE(PG8_SA(1, 0), a3, voffA);
            PG8_BAR; PG8_WAIT_L(0); PG8_MMA(1, 0, At, B0); PG8_BAR; PG8_SCHED;
            PG8_STAGE(PG8_SB(1, 1), b3 + hstepB, voffB);
            PG8_WAIT_V(6); PG8_BAR; PG8_MMA(1, 1, At, B1); PG8_BAR;
        }
        if (wr == 0) PG8_BAR;
        E(acc, cur, wr, wc, fr, fq);
        if (wr == 1) PG8_BAR;
        if (!has_next) break;
#pragma unroll
        for (int a = 0; a < 2; ++a)
#pragma unroll
            for (int b = 0; b < 2; ++b)
#pragma unroll
                for (int m = 0; m < 4; ++m)
#pragma unroll
                    for (int n = 0; n < 2; ++n) acc[a][b][m][n] = (i32x4){0, 0, 0, 0};
        cur = nxt; cA = nA; cB = nB; ++ui;
    }
    PG8_WAIT_V(0);
    if (wr == 0) PG8_BAR;
    PG8_BAR;
#undef PG8_SA
#undef PG8_SB
#undef PG8_STAGE
#undef PG8_LDA
#undef PG8_LDB
#undef PG8_MMA
#undef PG8_WAIT_V
#undef PG8_WAIT_L
#undef PG8_BAR
#undef PG8_SCHED
#undef PG8_APTR
#undef PG8_BPTR
}
}
using pg8::cvt_pk_bf16;


#define XB_TMO      128
#define XB_XCNT(j)  (256  + 64 * (j))
#define XB_XSUB(j)  (1280 + 64 * (j))
#define XB_XGEN(j)  (2304 + 64 * (j))
#define XB_TOP      3328
#define XB_TOPGEN   3392
#define XCD_BAR_WORDS 3456
#define XB_SPIN_CAP (1u << 18)
__device__ __forceinline__ unsigned xb_ld(unsigned* p)              { return __hip_atomic_load(p, __ATOMIC_RELAXED, __HIP_MEMORY_SCOPE_AGENT); }
__device__ __forceinline__ unsigned xb_add(unsigned* p, unsigned v) { return __hip_atomic_fetch_add(p, v, __ATOMIC_RELAXED, __HIP_MEMORY_SCOPE_AGENT); }
__device__ __forceinline__ unsigned xb_xcc_id() { return (unsigned)__builtin_amdgcn_s_getreg((3 << 11) | 20) & 0xFu; }
#define XB_SPIN(cond, bar) do { unsigned _sp = 0; while (cond) { __builtin_amdgcn_s_sleep(1); \
    if ((++_sp & 255u) == 0u) { if (xb_ld(&(bar)[XB_TMO])) break; if (_sp > XB_SPIN_CAP) { atomicAdd(&(bar)[XB_TMO], 1u); break; } } } } while (0)
struct XcdBarrier { unsigned* bar; unsigned x; volatile LAS unsigned* st; };
__device__ __forceinline__ void xcd_barrier_post(unsigned* bar) { if (threadIdx.x == 0) (void)xb_add(&bar[XB_XCNT(xb_xcc_id())], 1u); }
__device__ __forceinline__ void xcd_barrier_complete(unsigned* bar, unsigned x, unsigned& nloc, unsigned& nx) {
    const unsigned G = gridDim.x * gridDim.y * gridDim.z;
    unsigned sum, cnt, mine, sp = 0u;
    for (;;) {
        sum = 0u; cnt = 0u; mine = 0u;
#pragma unroll
        for (unsigned j = 0; j < 16; ++j) { const unsigned c = xb_ld(&bar[XB_XCNT(j)]); sum += c; cnt += (c > 0u) ? 1u : 0u; mine = (j == x) ? c : mine; }
        if (sum == G) break;
        __builtin_amdgcn_s_sleep(1);
        if ((++sp & 255u) == 0u) { if (xb_ld(&bar[XB_TMO])) break; if (sp > XB_SPIN_CAP) { atomicAdd(&bar[XB_TMO], 1u); break; } }
    }
    nloc = mine > 0u ? mine : 1u; nx = cnt > 0u ? cnt : 1u;
}
__device__ __forceinline__ void xcd_barrier(const XcdBarrier& b) {
    asm volatile("s_waitcnt vmcnt(0)" ::: "memory");
    __syncthreads();
    if (threadIdx.x == 0) {
        unsigned* bar = b.bar;
        __builtin_amdgcn_s_waitcnt(0);
        unsigned nloc = b.st[0], nx = b.st[1];
        if (nloc == 0u) { xcd_barrier_complete(bar, b.x, nloc, nx); b.st[0] = nloc; b.st[1] = nx; }
        const unsigned old = xb_add(&bar[XB_XSUB(b.x)], 1u);
        const unsigned gen = old / nloc;
        if (old + 1u == (gen + 1u) * nloc) {
            __builtin_amdgcn_fence(__ATOMIC_RELEASE, "agent");
            asm volatile("s_waitcnt vmcnt(0)" ::: "memory");
            const unsigned og = xb_add(&bar[XB_TOP], 1u);
            const unsigned tg = og / nx;
            if (og + 1u == (tg + 1u) * nx) xb_add(&bar[XB_TOPGEN], 1u);
            else XB_SPIN(xb_ld(&bar[XB_TOPGEN]) == tg, bar);
            __builtin_amdgcn_fence(__ATOMIC_ACQUIRE, "agent");
            xb_add(&bar[XB_XGEN(b.x)], 1u);
            asm volatile("s_waitcnt vmcnt(0)" ::: "memory");
        } else {
            XB_SPIN(xb_ld(&bar[XB_XGEN(b.x)]) == gen, bar);
            __builtin_amdgcn_fence(__ATOMIC_ACQUIRE, "agent");
            asm volatile("s_waitcnt vmcnt(0)" ::: "memory");
        }
    }
    __syncthreads();
}

__device__ __forceinline__ float sigm(float x) { return __builtin_amdgcn_rcpf(1.0f + __expf(-x)); }
__device__ __forceinline__ float gelu_tanh(float x) { return x * sigm(1.5957691216057308f * (x + 0.044715f * x * x * x)); }
__device__ __forceinline__ float sigm_gelu(float gb, float x) {
    const float t = x * x, u = __builtin_fmaf(t, -1.5957691216057308f * 1.4426950408889634f * 0.044715f, -1.5957691216057308f * 1.4426950408889634f);
    const float e1 = __builtin_amdgcn_exp2f(x * u), e2 = __builtin_amdgcn_exp2f(gb * -1.4426950408889634f);
    const float d = __builtin_fmaf(e1, e2, e1 + e2) + 1.0f;
    return x * __builtin_amdgcn_rcpf(d);
}
__device__ __forceinline__ float bf_lo(unsigned u) { return __uint_as_float(u << 16); }
__device__ __forceinline__ float bf_hi(unsigned u) { return __uint_as_float(u & 0xffff0000u); }
__device__ __forceinline__ float wave_sum(float v) {
#pragma unroll
    for (int o = 32; o >= 1; o >>= 1) v += __shfl_xor(v, o);
    return v;
}
__device__ __forceinline__ int slot8(int cit) { return (cit & ~31) | (((cit >> 2) & 1) << 4) | (((cit >> 3) & 3) << 2) | (cit & 3); }

struct Epi1 {
    bf16_t *sA, *p, *g2, *rx;
    __device__ __forceinline__ void operator()(const f32x4 (&acc)[2][2][4][2], const pg8::Unit& u, int wr, int wc, int fr, int fq) const {
        const int row0 = u.pm * 256 + wr * 64 + fr;
        if (u.pn < 16) {
            const int ch = u.pn * 64 + wc * 16 + fq * 4;
#pragma unroll
            for (int ai = 0; ai < 2; ++ai)
#pragma unroll
                for (int m = 0; m < 4; ++m) {
                    const size_t off = (size_t)(row0 + ai * 128 + m * 16) * D + ch;
                    const f32x4 cb = acc[ai][0][m][0], cc = acc[ai][0][m][1], cx = acc[ai][1][m][0], ga = acc[ai][1][m][1];
                    float s[4], q[4];
#pragma unroll
                    for (int j = 0; j < 4; ++j) { s[j] = sigm(ga[j]) * cb[j]; q[j] = cc[j] * cx[j]; }
                    u32x2 w0, w1; w0.x = cvt_pk_bf16(s[0], s[1]); w0.y = cvt_pk_bf16(s[2], s[3]); w1.x = cvt_pk_bf16(q[0], q[1]); w1.y = cvt_pk_bf16(q[2], q[3]);
                    *(u32x2*)(sA + off) = w0; *(u32x2*)(p + off) = w1;
                }
        } else if (u.pn < 24) {
            const int ch = (u.pn - 16) * 128 + wc * 32 + fq * 8;
#pragma unroll
            for (int ai = 0; ai < 2; ++ai)
#pragma unroll
                for (int m = 0; m < 4; ++m) {
                    const size_t off = (size_t)(row0 + ai * 128 + m * 16) * D + ch;
                    float v[8];
#pragma unroll
                    for (int n = 0; n < 2; ++n)
#pragma unroll
                        for (int j = 0; j < 4; ++j) v[4 * n + j] = sigm_gelu(acc[ai][1][m][n][j], acc[ai][0][m][n][j]);
                    u32x4 w; w.x = cvt_pk_bf16(v[0], v[1]); w.y = cvt_pk_bf16(v[2], v[3]); w.z = cvt_pk_bf16(v[4], v[5]); w.w = cvt_pk_bf16(v[6], v[7]);
                    *(u32x4*)(g2 + off) = w;
                }
        } else {
#pragma unroll
            for (int ai = 0; ai < 2; ++ai)
#pragma unroll
                for (int m = 0; m < 4; ++m)
#pragma unroll
                    for (int bj = 0; bj < 2; ++bj) {
                        const size_t off = (size_t)(row0 + ai * 128 + m * 16) * D + (u.pn - 24) * 256 + bj * 128 + wc * 32 + fq * 8;
                        const f32x4 v0 = acc[ai][bj][m][0], v1 = acc[ai][bj][m][1];
                        u32x4 w; w.x = cvt_pk_bf16(v0[0], v0[1]); w.y = cvt_pk_bf16(v0[2], v0[3]); w.z = cvt_pk_bf16(v1[0], v1[1]); w.w = cvt_pk_bf16(v1[2], v1[3]);
                        *(u32x4*)(rx + off) = w;
                    }
        }
    }
};

template <class Inner> struct EpiI8 {
    const float* sa; const float* sb; Inner inner; int pn_off;
    __device__ __forceinline__ void operator()(const i32x4 (&acc)[2][2][4][2], const pg8::Unit& u, int wr, int wc, int fr, int fq) const {
        const int row0 = u.pm * 256 + wr * 64 + fr, col0 = u.pn * 256 + wc * 32 + 4 * fq;
        f32x4 sbv[2][2]; float sav[2][4];
#pragma unroll
        for (int bj = 0; bj < 2; ++bj)
#pragma unroll
            for (int n = 0; n < 2; ++n) sbv[bj][n] = *(const f32x4*)(sb + col0 + bj * 128 + n * 16);
#pragma unroll
        for (int ai = 0; ai < 2; ++ai)
#pragma unroll
            for (int m = 0; m < 4; ++m) sav[ai][m] = sa[row0 + ai * 128 + m * 16];
        f32x4 f[2][2][4][2];
#pragma unroll
        for (int ai = 0; ai < 2; ++ai)
#pragma unroll
            for (int bj = 0; bj < 2; ++bj)
#pragma unroll
                for (int m = 0; m < 4; ++m)
#pragma unroll
                    for (int n = 0; n < 2; ++n) { const i32x4 q = acc[ai][bj][m][n]; f[ai][bj][m][n] = (f32x4){(float)q.x, (float)q.y, (float)q.z, (float)q.w} * sbv[bj][n] * sav[ai][m]; }
        const pg8::Unit ui{u.pm, u.pn + pn_off};
        inner(f, ui, wr, wc, fr, fq);
    }
};
struct EpiRG {
    const bf16_t* U; float* A; float* BX; const float* ba; const float* bx; const float* ls8;
    __device__ __forceinline__ void operator()(const f32x4 (&acc)[2][2][4][2], const pg8::Unit& u, int wr, int wc, int fr, int fq) const {
        const int row0 = u.pm * 256 + wr * 64 + fr, ch = u.pn * 128 + wc * 32 + fq * 8;
        f32x4 ba4[2], bx4[2], ls4[2];
#pragma unroll
        for (int n = 0; n < 2; ++n) { ba4[n] = *(const f32x4*)(ba + ch + 4 * n); bx4[n] = *(const f32x4*)(bx + ch + 4 * n); ls4[n] = *(const f32x4*)(ls8 + ch + 4 * n); }
#pragma unroll
        for (int ai = 0; ai < 2; ++ai)
#pragma unroll
            for (int m = 0; m < 4; ++m) {
                const int row = row0 + ai * 128 + m * 16; const bool first = (row & (SEQ - 1)) == 0;
                const size_t off = (size_t)row * D + ch;
                const u32x4 uu = *(const u32x4*)(U + off);
                const float uf[8] = {bf_lo(uu.x), bf_hi(uu.x), bf_lo(uu.y), bf_hi(uu.y), bf_lo(uu.z), bf_hi(uu.z), bf_lo(uu.w), bf_hi(uu.w)};
#pragma unroll
                for (int n = 0; n < 2; ++n) {
                    f32x4 av, bv;
#pragma unroll
                    for (int j = 0; j < 4; ++j) {
                        const float r = sigm(acc[ai][0][m][n][j] + ba4[n][j]), ig = sigm(acc[ai][1][m][n][j] + bx4[n][j]);
                        const float a = __expf(r * ls4[n][j]);
                        const float mult = first ? 1.0f : sqrtf(fmaxf(1.0f - a * a, 0.0f));
                        av[j] = a; bv[j] = mult * ig * uf[4 * n + j];
                    }
                    *(f32x4*)(A + off + 4 * n) = av; *(f32x4*)(BX + off + 4 * n) = bv;
                }
            }
    }
};

template <int N> __device__ __forceinline__ float dpp_shr(float v, float ident) {
    return __int_as_float(__builtin_amdgcn_update_dpp(__float_as_int(ident), __float_as_int(v), 0x110 | N, 0xf, 0xf, false));
}
struct EpiRG2 {
    const bf16_t* U; bf16_t* HL; bf16_t* PC; float* AT; float* HT; const float* ba; const float* bx; const float* ls8; LAS float* xch;
    __device__ __forceinline__ void operator()(f32x4 (&acc)[2][2][4][2], const pg8::Unit& u, int wr, int wc, int fr, int fq) const {
        const int ch = u.pn * 128 + wc * 32 + fq * 8, tok0 = u.pm * 256 + 8 * (fr + 16 * wr);
        float hh[8], pp[8];
        {
            f32x4 ba4[2], bx4[2], ls4[2];
#pragma unroll
            for (int n = 0; n < 2; ++n) { ba4[n] = *(const f32x4*)(ba + ch + 4 * n) * -1.4426950408889634f; bx4[n] = *(const f32x4*)(bx + ch + 4 * n) * -1.4426950408889634f; ls4[n] = *(const f32x4*)(ls8 + ch + 4 * n) * 1.4426950408889634f; }
#pragma unroll
            for (int c = 0; c < 8; ++c) { hh[c] = 0.f; pp[c] = 1.f; }
            u32x4 uq[8];
#pragma unroll
            for (int i = 0; i < 8; ++i) uq[i] = *(const u32x4*)((const char*)U + ((unsigned)(tok0 + i) * D + ch) * 2u);
#pragma unroll
            for (int ai = 0; ai < 2; ++ai)
#pragma unroll
                for (int m = 0; m < 4; ++m) {
                    __builtin_amdgcn_sched_barrier(0);
                    const int row = tok0 + 4 * ai + m; const bool first = (row & (SEQ - 1)) == 0;
                    const u32x4 uu = uq[4 * ai + m];
                    const float uf[8] = {bf_lo(uu.x), bf_hi(uu.x), bf_lo(uu.y), bf_hi(uu.y), bf_lo(uu.z), bf_hi(uu.z), bf_lo(uu.w), bf_hi(uu.w)};
#pragma unroll
                    for (int n = 0; n < 2; ++n)
#pragma unroll
                        for (int j = 0; j < 4; ++j) {
                            const int c = 4 * n + j;
                            const float r = __builtin_amdgcn_rcpf(1.0f + __builtin_amdgcn_exp2f(__builtin_fmaf(acc[ai][0][m][n][j], -1.4426950408889634f, ba4[n][j])));
                            const float ig = __builtin_amdgcn_rcpf(1.0f + __builtin_amdgcn_exp2f(__builtin_fmaf(acc[ai][1][m][n][j], -1.4426950408889634f, bx4[n][j])));
                            const float a = __builtin_amdgcn_exp2f(r * ls4[n][j]);
                            float mult = __builtin_amdgcn_sqrtf(__builtin_fmaf(-a, a, 1.0f));
                            if (ai == 0 && m == 0) mult = first ? 1.0f : mult;
                            hh[c] = a * hh[c] + mult * ig * uf[c]; pp[c] *= a;
                            acc[ai][0][m][n][j] = hh[c]; acc[ai][1][m][n][j] = pp[c];
                        }
                }
        }
        float ea[8], eh[8];
#pragma unroll
        for (int c = 0; c < 8; ++c) {
            float ia = pp[c], ih = hh[c], au, hu;
            au = dpp_shr<1>(ia, 1.f); hu = dpp_shr<1>(ih, 0.f); ih = ia * hu + ih; ia = au * ia;
            au = dpp_shr<2>(ia, 1.f); hu = dpp_shr<2>(ih, 0.f); ih = ia * hu + ih; ia = au * ia;
            au = dpp_shr<4>(ia, 1.f); hu = dpp_shr<4>(ih, 0.f); ih = ia * hu + ih; ia = au * ia;
            au = dpp_shr<8>(ia, 1.f); hu = dpp_shr<8>(ih, 0.f); ih = ia * hu + ih; ia = au * ia;
            ea[c] = dpp_shr<1>(ia, 1.f); eh[c] = dpp_shr<1>(ih, 0.f);
            pp[c] = ia; hh[c] = ih;
        }
        LAS float* xw = xch + (wc * 4 + fq) * 16;
        if (wr == 0 && fr == 15) {
#pragma unroll
            for (int c = 0; c < 8; ++c) { xw[2 * c] = pp[c]; xw[2 * c + 1] = hh[c]; }
        }
        asm volatile("s_waitcnt lgkmcnt(0)" ::: "memory");
        __builtin_amdgcn_s_barrier();
        asm volatile("" ::: "memory");
        if (wr == 1) {
#pragma unroll
            for (int c = 0; c < 8; ++c) {
                const float wa = xw[2 * c], wh = xw[2 * c + 1];
                if (fr == 15) { AT[(size_t)u.pm * D + ch + c] = wa * pp[c]; HT[(size_t)u.pm * D + ch + c] = pp[c] * wh + hh[c]; }
                eh[c] = ea[c] * wh + eh[c]; ea[c] = wa * ea[c];
            }
        }
#pragma unroll
        for (int ai = 0; ai < 2; ++ai)
#pragma unroll
            for (int m = 0; m < 4; ++m) {
                const unsigned off = ((unsigned)(tok0 + 4 * ai + m) * D + ch) * 2u;
                float hl[8], pc[8];
#pragma unroll
                for (int n = 0; n < 2; ++n)
#pragma unroll
                    for (int j = 0; j < 4; ++j) { const int c = 4 * n + j; hl[c] = acc[ai][0][m][n][j] + acc[ai][1][m][n][j] * eh[c]; pc[c] = acc[ai][1][m][n][j] * ea[c]; }
                u32x4 w0, w1;
                w0.x = cvt_pk_bf16(hl[0], hl[1]); w0.y = cvt_pk_bf16(hl[2], hl[3]); w0.z = cvt_pk_bf16(hl[4], hl[5]); w0.w = cvt_pk_bf16(hl[6], hl[7]);
                w1.x = cvt_pk_bf16(pc[0], pc[1]); w1.y = cvt_pk_bf16(pc[2], pc[3]); w1.z = cvt_pk_bf16(pc[4], pc[5]); w1.w = cvt_pk_bf16(pc[6], pc[7]);
                *(u32x4*)((char*)HL + off) = w0; *(u32x4*)((char*)PC + off) = w1;
            }
    }
};
struct EpiRes {
    const float* base; float* out; const float* gate;
    __device__ __forceinline__ void operator()(const f32x4 (&acc)[2][2][4][2], const pg8::Unit& u, int wr, int wc, int fr, int fq) const {
        const int row0 = u.pm * 256 + wr * 64 + fr, col0 = u.pn * 256 + wc * 32 + 4 * fq;
        const float* gp = gate + (size_t)(u.pm >> 5) * NMOD + col0;
        f32x4 gv[2][2];
#pragma unroll
        for (int bj = 0; bj < 2; ++bj)
#pragma unroll
            for (int n = 0; n < 2; ++n) gv[bj][n] = *(const f32x4*)(gp + bj * 128 + n * 16);
#pragma unroll
        for (int ai = 0; ai < 2; ++ai)
#pragma unroll
            for (int m = 0; m < 4; ++m) {
                const size_t off = (size_t)(row0 + ai * 128 + m * 16) * D + col0;
#pragma unroll
                for (int bj = 0; bj < 2; ++bj)
#pragma unroll
                    for (int n = 0; n < 2; ++n) { const f32x4 b = *(const f32x4*)(base + off + bj * 128 + n * 16); *(f32x4*)(out + off + bj * 128 + n * 16) = b + gv[bj][n] * acc[ai][bj][m][n]; }
            }
    }
};

template <int MODE, bool Q8 = false> struct EpiResNorm {
    const void* base; void* out; const float* gate; float* rowss; unsigned* cnt; const float* gvec; const float* modb; bf16_t* H; unsigned* rowmx; float* sa2; const float* shmax;
    __device__ __forceinline__ void operator()(f32x4 (&acc)[2][2][4][2], const pg8::Unit& u, int wr, int wc, int fr, int fq) const {
        const int row0 = u.pm * 256 + wr * 64 + fr, colb = u.pn * 256 + wc * 32 + 8 * fq;
        {
            const float* gp = gate + (size_t)(u.pm >> 5) * NMOD + colb;
            f32x4 gv[2][2], gq[2][2], sq[2][2];
#pragma unroll
            for (int bj = 0; bj < 2; ++bj)
#pragma unroll
                for (int n = 0; n < 2; ++n) { gv[bj][n] = *(const f32x4*)(gp + bj * 128 + n * 4);
                    if (Q8) { gq[bj][n] = *(const f32x4*)(gvec + colb + bj * 128 + n * 4) * (*(const f32x4*)(modb + (size_t)(u.pm >> 5) * NMOD + colb + 4096 + bj * 128 + n * 4) + 1.0f);
                        sq[bj][n] = __builtin_elementwise_abs(*(const f32x4*)(modb + (size_t)(u.pm >> 5) * NMOD + colb + 3072 + bj * 128 + n * 4)); } }
#pragma unroll
            for (int ai = 0; ai < 2; ++ai)
#pragma unroll
                for (int m = 0; m < 4; ++m) {
                    const int row = row0 + ai * 128 + m * 16; const unsigned off = ((unsigned)row * D + colb) * 4u;
                    float ss = 0.f, mq = 0.f;
#pragma unroll
                    for (int bj = 0; bj < 2; ++bj) {
                        f32x4 b0, b1;
                        if (MODE == 0) { b0 = *(const f32x4*)((const char*)base + off + bj * 512); b1 = *(const f32x4*)((const char*)base + off + bj * 512 + 16); }
                        else { const u32x4 q = *(const u32x4*)((const char*)base + (off >> 1) + bj * 256); b0 = (f32x4){bf_lo(q.x), bf_hi(q.x), bf_lo(q.y), bf_hi(q.y)}; b1 = (f32x4){bf_lo(q.z), bf_hi(q.z), bf_lo(q.w), bf_hi(q.w)}; }
#pragma unroll
                        for (int n = 0; n < 2; ++n) { const f32x4 v = (n ? b1 : b0) + gv[bj][n] * acc[ai][bj][m][n];
                            acc[ai][bj][m][n] = v; ss += (v.x * v.x + v.y * v.y) + (v.z * v.z + v.w * v.w);
                            if (Q8) { const f32x4 t = __builtin_elementwise_abs(v * gq[bj][n]) + sq[bj][n]; mq = fmaxf(mq, fmaxf(fmaxf(t.x, t.y), fmaxf(t.z, t.w))); } }
                    }
                    ss += __shfl_xor(ss, 16); ss += __shfl_xor(ss, 32);
                    if (Q8) { mq = fmaxf(mq, __shfl_xor(mq, 16)); mq = fmaxf(mq, __shfl_xor(mq, 32)); }
                    if (fq == 0) { (void)__hip_atomic_fetch_add(rowss + row, ss, __ATOMIC_RELAXED, __HIP_MEMORY_SCOPE_AGENT);
                        if (Q8) (void)__hip_atomic_fetch_max(rowmx + row, __float_as_uint(mq), __ATOMIC_RELAXED, __HIP_MEMORY_SCOPE_AGENT); }
                }
        }
        asm volatile("s_waitcnt vmcnt(0)" ::: "memory");
        unsigned* cw = cnt + (2 * u.pm + wr) * 64;
        if (fr == 0 && fq == 0) (void)__hip_atomic_fetch_add(cw, 1u, __ATOMIC_RELAXED, __HIP_MEMORY_SCOPE_AGENT);
        { unsigned spins = 0;
          while ((unsigned)__builtin_amdgcn_readfirstlane(__hip_atomic_load(cw, __ATOMIC_RELAXED, __HIP_MEMORY_SCOPE_AGENT)) < 16u) { __builtin_amdgcn_s_sleep(1); if (++spins > (1u << 17)) break; } }
        asm volatile("" ::: "memory");
        float rs[2][4];
#pragma unroll
        for (int ai = 0; ai < 2; ++ai)
#pragma unroll
            for (int m = 0; m < 4; ++m) rs[ai][m] = rsqrtf(__hip_atomic_load(rowss + row0 + ai * 128 + m * 16, __ATOMIC_RELAXED, __HIP_MEMORY_SCOPE_AGENT) * (1.0f / D) + EPS);
        if (MODE == 1) {
            f32x4 gg[2][2];
#pragma unroll
            for (int bj = 0; bj < 2; ++bj)
#pragma unroll
                for (int n = 0; n < 2; ++n) gg[bj][n] = *(const f32x4*)(gvec + colb + bj * 128 + n * 4);
#pragma unroll
            for (int ai = 0; ai < 2; ++ai)
#pragma unroll
                for (int m = 0; m < 4; ++m) {
                    const unsigned off = ((unsigned)(row0 + ai * 128 + m * 16) * D + colb) * 4u;
#pragma unroll
                    for (int bj = 0; bj < 2; ++bj)
#pragma unroll
                        for (int n = 0; n < 2; ++n) *(f32x4*)((char*)out + off + bj * 512 + n * 16) = acc[ai][bj][m][n] * rs[ai][m] * gg[bj][n];
                }
        } else {
            const float* mb = modb + (size_t)(u.pm >> 5) * NMOD + colb;
            float qinv[2][4];
            if (Q8) { const float shm = shmax[u.pm >> 5];
#pragma unroll
                for (int ai = 0; ai < 2; ++ai)
#pragma unroll
                    for (int m = 0; m < 4; ++m) { const int row = row0 + ai * 128 + m * 16;
                        const float bound = rs[ai][m] * __uint_as_float(__hip_atomic_load(rowmx + row, __ATOMIC_RELAXED, __HIP_MEMORY_SCOPE_AGENT)) + fmaxf(0.0f, 1.0f - rs[ai][m]) * shm;
                        qinv[ai][m] = bound > 0.f ? 127.0f / bound : 0.f;
                        if (u.pn == 0 && wc == 0 && fq == 0) sa2[row] = bound * (1.0f / 127.0f); } }
            f32x4 gs[2][2], sh[2][2];
#pragma unroll
            for (int bj = 0; bj < 2; ++bj)
#pragma unroll
                for (int n = 0; n < 2; ++n) { gs[bj][n] = *(const f32x4*)(gvec + colb + bj * 128 + n * 4) * (*(const f32x4*)(mb + 4096 + bj * 128 + n * 4) + 1.0f); sh[bj][n] = *(const f32x4*)(mb + 3072 + bj * 128 + n * 4); }
#pragma unroll
            for (int ai = 0; ai < 2; ++ai)
#pragma unroll
                for (int m = 0; m < 4; ++m) {
                    const unsigned off = ((unsigned)(row0 + ai * 128 + m * 16) * D + colb) * 4u;
#pragma unroll
                    for (int bj = 0; bj < 2; ++bj) {
                        const f32x4 v0 = acc[ai][bj][m][0], v1 = acc[ai][bj][m][1];
                        u32x4 xw; xw.x = cvt_pk_bf16(v0.x, v0.y); xw.y = cvt_pk_bf16(v0.z, v0.w); xw.z = cvt_pk_bf16(v1.x, v1.y); xw.w = cvt_pk_bf16(v1.z, v1.w);
                        *(u32x4*)((char*)out + (off >> 1) + bj * 256) = xw;
                        const f32x4 y0 = v0 * rs[ai][m] * gs[bj][0] + sh[bj][0], y1 = v1 * rs[ai][m] * gs[bj][1] + sh[bj][1];
                        if (Q8) { const f32x4 q0 = y0 * qinv[ai][m], q1 = y1 * qinv[ai][m];
                            const int a0 = (int)__builtin_rintf(q0.x), a1 = (int)__builtin_rintf(q0.y), a2 = (int)__builtin_rintf(q0.z), a3 = (int)__builtin_rintf(q0.w);
                            const int c0 = (int)__builtin_rintf(q1.x), c1 = (int)__builtin_rintf(q1.y), c2 = (int)__builtin_rintf(q1.z), c3 = (int)__builtin_rintf(q1.w);
                            u32x2 w; w.x = (unsigned)(a0 & 0xff) | ((unsigned)(a1 & 0xff) << 8) | ((unsigned)(a2 & 0xff) << 16) | ((unsigned)a3 << 24);
                            w.y = (unsigned)(c0 & 0xff) | ((unsigned)(c1 & 0xff) << 8) | ((unsigned)(c2 & 0xff) << 16) | ((unsigned)c3 << 24);
                            *(u32x2*)((char*)H + (off >> 2) + bj * 128) = w; }
                        else { u32x4 w; w.x = cvt_pk_bf16(y0.x, y0.y); w.y = cvt_pk_bf16(y0.z, y0.w); w.z = cvt_pk_bf16(y1.x, y1.y); w.w = cvt_pk_bf16(y1.z, y1.w); *(u32x4*)((char*)H + (off >> 1) + bj * 256) = w; }
                    }
                }
        }
    }
};
struct EpiConvA {
    bf16_t* YA; bf16_t* PT; bf16_t* ST; const float* cw;
    __device__ __forceinline__ void operator()(f32x4 (&acc)[2][2][4][2], const pg8::Unit& u, int wr, int wc, int fr, int fq) const {
        const int ch = u.pn * 64 + wc * 16 + fq * 4, tok0 = u.pm * 256 + 8 * (fr + 16 * wr), hb = 2 * u.pm + wr;
        const f32x4 w0 = *(const f32x4*)(cw + ch), w1 = *(const f32x4*)(cw + D + ch), w2 = *(const f32x4*)(cw + 2 * D + ch);
#pragma unroll
        for (int ai = 0; ai < 2; ++ai)
#pragma unroll
            for (int m = 0; m < 4; ++m) {
                const f32x4 cb = acc[ai][0][m][0], cc = acc[ai][0][m][1], cx = acc[ai][1][m][0], ga = acc[ai][1][m][1];
                f32x4 sv;
#pragma unroll
                for (int j = 0; j < 4; ++j) sv[j] = sigm(ga[j]) * cb[j];
                acc[ai][0][m][0] = sv; acc[ai][0][m][1] = cc * cx;
            }
        const f32x4 p6 = acc[1][0][2][1], p7 = acc[1][0][3][1];
        f32x4 a, b;
#pragma unroll
        for (int j = 0; j < 4; ++j) { a[j] = dpp_shr<1>(p6[j], 0.f); b[j] = dpp_shr<1>(p7[j], 0.f); }
        if (fr == 15) { u32x2 q6, q7; q6.x = cvt_pk_bf16(p6.x, p6.y); q6.y = cvt_pk_bf16(p6.z, p6.w); q7.x = cvt_pk_bf16(p7.x, p7.y); q7.y = cvt_pk_bf16(p7.z, p7.w);
            *(u32x2*)(PT + (size_t)(hb * 2 + 0) * D + ch) = q6; *(u32x2*)(PT + (size_t)(hb * 2 + 1) * D + ch) = q7; }
        if (fr == 0) { const f32x4 s0 = acc[0][0][0][0], s1 = acc[0][0][1][0]; u32x2 q0, q1; q0.x = cvt_pk_bf16(s0.x, s0.y); q0.y = cvt_pk_bf16(s0.z, s0.w); q1.x = cvt_pk_bf16(s1.x, s1.y); q1.y = cvt_pk_bf16(s1.z, s1.w);
            *(u32x2*)(ST + (size_t)(hb * 2 + 0) * D + ch) = q0; *(u32x2*)(ST + (size_t)(hb * 2 + 1) * D + ch) = q1; }
#pragma unroll
        for (int ai = 0; ai < 2; ++ai)
#pragma unroll
            for (int m = 0; m < 4; ++m) {
                const f32x4 pc = acc[ai][0][m][1], y = acc[ai][0][m][0] * (w0 * a + w1 * b + w2 * pc);
                u32x2 w; w.x = cvt_pk_bf16(y.x, y.y); w.y = cvt_pk_bf16(y.z, y.w);
                *(u32x2*)((char*)YA + ((unsigned)(tok0 + 4 * ai + m) * D + ch) * 2u) = w;
                a = b; b = pc;
            }
    }
};

struct EpiConvC {
    const float* sa; const float* sb; bf16_t* U; bf16_t* RXS; const float* cw; const float* cbias;
    __device__ __forceinline__ void operator()(const i32x4 (&acc)[2][2][4][2], const pg8::Unit& u, int wr, int wc, int fr, int fq) const {
        const int tok0 = u.pm * 256 + 8 * (fr + 16 * wr), hb = 2 * u.pm + wr, col0 = u.pn * 256 + wc * 32 + 4 * fq;
        float sav[8];
#pragma unroll
        for (int i = 0; i < 8; ++i) sav[i] = sa[tok0 + i];
#pragma unroll
        for (int bj = 0; bj < 2; ++bj) {
            u32x2 vq[8];
#pragma unroll
            for (int n = 0; n < 2; ++n) {
                __builtin_amdgcn_sched_barrier(0);
                const int ch = u.pn * 256 + bj * 128 + wc * 32 + fq * 8 + 4 * n;
                const f32x4 sbn = *(const f32x4*)(sb + col0 + bj * 128 + n * 16);
                const f32x4 w0 = *(const f32x4*)(cw + ch), w1 = *(const f32x4*)(cw + D + ch), w2 = *(const f32x4*)(cw + 2 * D + ch), w3 = *(const f32x4*)(cw + 3 * D + ch), bb = *(const f32x4*)(cbias + ch);
                f32x4 r[8];
#pragma unroll
                for (int ai = 0; ai < 2; ++ai)
#pragma unroll
                    for (int m = 0; m < 4; ++m) { const i32x4 q = acc[ai][bj][m][n]; r[4 * ai + m] = (f32x4){(float)q.x, (float)q.y, (float)q.z, (float)q.w} * sbn * sav[4 * ai + m]; }
                f32x4 pv[3];
#pragma unroll
                for (int k = 0; k < 3; ++k)
#pragma unroll
                    for (int j = 0; j < 4; ++j) pv[k][j] = dpp_shr<1>(r[5 + k][j], 0.f);
                if (fr == 0 || fr == 15) {
#pragma unroll
                    for (int k = 0; k < 3; ++k) { const f32x4 x = (fr == 0) ? r[k] : r[5 + k]; u32x2 q; q.x = cvt_pk_bf16(x.x, x.y); q.y = cvt_pk_bf16(x.z, x.w);
                        *(u32x2*)(RXS + (size_t)(hb * 6 + (fr == 0 ? k : 3 + k)) * D + ch) = q; }
                }
#pragma unroll
                for (int i = 0; i < 8; ++i) {
                    const f32x4 x3 = (i >= 3) ? r[i >= 3 ? i - 3 : 0] : pv[i >= 3 ? 0 : i];
                    const f32x4 x2 = (i >= 2) ? r[i >= 2 ? i - 2 : 0] : pv[i >= 2 ? 0 : i + 1];
                    const f32x4 x1 = (i >= 1) ? r[i >= 1 ? i - 1 : 0] : pv[2];
                    const f32x4 v = bb + w0 * x3 + w1 * x2 + w2 * x1 + w3 * r[i];
                    u32x2 q; q.x = cvt_pk_bf16(v.x, v.y); q.y = cvt_pk_bf16(v.z, v.w);
                    if (n == 0) vq[i] = q;
                    else *(u32x4*)((char*)U + ((unsigned)(tok0 + i) * D + ch - 4) * 2u) = (u32x4){vq[i].x, vq[i].y, q.x, q.y};
                }
            }
        }
    }
};

struct EpiRG3 {
    const bf16_t* U; bf16_t* MERGED; unsigned long long* TOT; unsigned* FLAG; const float* ba; const float* bx; const float* ls8; LAS float* xch;
    const bf16_t* YA; const bf16_t* G2; const bf16_t* PT; const bf16_t* ST; const float* cw;
    __device__ __forceinline__ void operator()(f32x4 (&acc)[2][2][4][2], const pg8::Unit& u, int wr, int wc, int fr_, int fq_) const {
        int fr = fr_, fq = fq_; asm volatile("" : "+v"(fr), "+v"(fq));
        const int ch = u.pn * 128 + wc * 32 + fq * 8, tok0 = u.pm * 256 + 8 * (fr + 16 * wr);
        float hh[8], pp[8];
        {
            f32x4 ba4[2], bx4[2], ls4[2];
#pragma unroll
            for (int n = 0; n < 2; ++n) { ba4[n] = *(const f32x4*)((const char*)ba + (unsigned)(ch + 4 * n) * 4u) * -1.4426950408889634f; bx4[n] = *(const f32x4*)((const char*)bx + (unsigned)(ch + 4 * n) * 4u) * -1.4426950408889634f; ls4[n] = *(const f32x4*)((const char*)ls8 + (unsigned)(ch + 4 * n) * 4u) * 1.4426950408889634f; }
#pragma unroll
            for (int c = 0; c < 8; ++c) { hh[c] = 0.f; pp[c] = 1.f; }
            u32x4 uq[8];
#pragma unroll
            for (int i = 0; i < 8; ++i) uq[i] = *(const u32x4*)((const char*)U + ((unsigned)(tok0 + i) * D + ch) * 2u);
#pragma unroll
            for (int ai = 0; ai < 2; ++ai)
#pragma unroll
                for (int m = 0; m < 4; ++m) {
                    __builtin_amdgcn_sched_barrier(0);
                    const int row = tok0 + 4 * ai + m; const bool first = (row & (SEQ - 1)) == 0;
                    const u32x4 uu = uq[4 * ai + m];
                    const float uf[8] = {bf_lo(uu.x), bf_hi(uu.x), bf_lo(uu.y), bf_hi(uu.y), bf_lo(uu.z), bf_hi(uu.z), bf_lo(uu.w), bf_hi(uu.w)};
#pragma unroll
                    for (int n = 0; n < 2; ++n)
#pragma unroll
                        for (int j = 0; j < 4; ++j) {
                            const int c = 4 * n + j;
                            const float r = __builtin_amdgcn_rcpf(1.0f + __builtin_amdgcn_exp2f(__builtin_fmaf(acc[ai][0][m][n][j], -1.4426950408889634f, ba4[n][j])));
                            const float ig = __builtin_amdgcn_rcpf(1.0f + __builtin_amdgcn_exp2f(__builtin_fmaf(acc[ai][1][m][n][j], -1.4426950408889634f, bx4[n][j])));
                            const float a = __builtin_amdgcn_exp2f(r * ls4[n][j]);
                            float mult = __builtin_amdgcn_sqrtf(__builtin_fmaf(-a, a, 1.0f));
                            if (ai == 0 && m == 0) mult = first ? 1.0f : mult;
                            hh[c] = a * hh[c] + mult * ig * uf[c]; pp[c] *= a;
                            acc[ai][0][m][n][j] = hh[c]; acc[ai][1][m][n][j] = pp[c];
                        }
                }
        }
        __builtin_amdgcn_sched_barrier(0);
        float ea[8], eh[8];
#pragma unroll
        for (int c = 0; c < 8; ++c) {
            float ia = pp[c], ih = hh[c], au, hu;
            au = dpp_shr<1>(ia, 1.f); hu = dpp_shr<1>(ih, 0.f); ih = ia * hu + ih; ia = au * ia;
            au = dpp_shr<2>(ia, 1.f); hu = dpp_shr<2>(ih, 0.f); ih = ia * hu + ih; ia = au * ia;
            au = dpp_shr<4>(ia, 1.f); hu = dpp_shr<4>(ih, 0.f); ih = ia * hu + ih; ia = au * ia;
            au = dpp_shr<8>(ia, 1.f); hu = dpp_shr<8>(ih, 0.f); ih = ia * hu + ih; ia = au * ia;
            ea[c] = dpp_shr<1>(ia, 1.f); eh[c] = dpp_shr<1>(ih, 0.f);
            pp[c] = ia; hh[c] = ih;
        }
        LAS float* xw = xch + (wc * 4 + fq) * 16;
        if (wr == 0 && fr == 15) {
#pragma unroll
            for (int c = 0; c < 8; ++c) { xw[2 * c] = pp[c]; xw[2 * c + 1] = hh[c]; }
        }
        asm volatile("s_waitcnt lgkmcnt(0)" ::: "memory");
        __builtin_amdgcn_s_barrier();
        asm volatile("" ::: "memory");
        if (wr == 1) {
#pragma unroll
            for (int c = 0; c < 8; ++c) {
                const float wa = xw[2 * c], wh = xw[2 * c + 1];
                if (fr == 15) { const float ta = wa * pp[c], th = pp[c] * wh + hh[c];
                    __hip_atomic_store((unsigned long long*)((char*)TOT + ((unsigned)(u.pm * D + ch + c)) * 8u), ((unsigned long long)__float_as_uint(th) << 32) | __float_as_uint(ta), __ATOMIC_RELAXED, __HIP_MEMORY_SCOPE_AGENT); }
                eh[c] = ea[c] * wh + eh[c]; ea[c] = wa * ea[c];
            }
            asm volatile("s_waitcnt vmcnt(0)" ::: "memory");
            if (fr == 15 && fq == 0) (void)__hip_atomic_fetch_add((unsigned*)((char*)FLAG + (unsigned)(u.pm * 8 + u.pn) * 4u), 1u, __ATOMIC_RELAXED, __HIP_MEMORY_SCOPE_AGENT);
        }
        __builtin_amdgcn_sched_barrier(0);
        {
            const int kb = u.pm & 31;
            float ca[8], chh[8];
#pragma unroll
            for (int c = 0; c < 8; ++c) { ca[c] = 1.f; chh[c] = 0.f; }
#pragma unroll
            for (int q = 0; q < 2; ++q) {
                const int pidx = 2 * fr + q;
                if (pidx < kb) {
                    const int k = u.pm - kb + pidx; unsigned spins = 0;
                    while (__hip_atomic_load((const unsigned*)((const char*)FLAG + (unsigned)(k * 8 + u.pn) * 4u), __ATOMIC_RELAXED, __HIP_MEMORY_SCOPE_AGENT) < 4u) { __builtin_amdgcn_s_sleep(1); if (++spins > (1u << 16)) break; }
#pragma unroll
                    for (int c = 0; c < 8; ++c) { const unsigned long long w = __hip_atomic_load((const unsigned long long*)((const char*)TOT + ((unsigned)(k * D + ch + c)) * 8u), __ATOMIC_RELAXED, __HIP_MEMORY_SCOPE_AGENT);
                        const float ta = __uint_as_float((unsigned)w), th = __uint_as_float((unsigned)(w >> 32)); chh[c] = ta * chh[c] + th; ca[c] = ta * ca[c]; }
                }
            }
#pragma unroll
            for (int c = 0; c < 8; ++c) {
                float ia = ca[c], ih = chh[c], au, hu;
                au = dpp_shr<1>(ia, 1.f); hu = dpp_shr<1>(ih, 0.f); ih = ia * hu + ih; ia = au * ia;
                au = dpp_shr<2>(ia, 1.f); hu = dpp_shr<2>(ih, 0.f); ih = ia * hu + ih; ia = au * ia;
                au = dpp_shr<4>(ia, 1.f); hu = dpp_shr<4>(ih, 0.f); ih = ia * hu + ih; ia = au * ia;
                au = dpp_shr<8>(ia, 1.f); hu = dpp_shr<8>(ih, 0.f); ih = ia * hu + ih; ia = au * ia;
                const float carry = __shfl(ih, fq * 16 + 15);
                eh[c] = __builtin_fmaf(ea[c], carry, eh[c]);
            }
        }
        __builtin_amdgcn_sched_barrier(0);
        u32x4 qy[4], qg[4];
#pragma unroll
        for (int i = 0; i < 4; ++i) { const unsigned off = ((unsigned)(tok0 + i) * D + ch) * 2u; qy[i] = *(const u32x4*)((const char*)YA + off); qg[i] = *(const u32x4*)((const char*)G2 + off); }
#pragma unroll
        for (int half = 0; half < 2; ++half) {
            __builtin_amdgcn_sched_barrier(0);
            u32x4 ny[4], ng[4];
            if (half == 0) {
#pragma unroll
                for (int i = 0; i < 4; ++i) { const unsigned off = ((unsigned)(tok0 + 4 + i) * D + ch) * 2u; ny[i] = *(const u32x4*)((const char*)YA + off); ng[i] = *(const u32x4*)((const char*)G2 + off); }
            }
#pragma unroll
            for (int m = 0; m < 4; ++m) {
                const int ai = half, i = 4 * ai + m; const unsigned off = ((unsigned)(tok0 + i) * D + ch) * 2u;
                const unsigned yw[4] = {qy[m].x, qy[m].y, qy[m].z, qy[m].w}, gw4[4] = {qg[m].x, qg[m].y, qg[m].z, qg[m].w};
                unsigned ow[4];
#pragma unroll
                for (int q = 0; q < 4; ++q) {
                    const int c0 = 2 * q, c1 = 2 * q + 1, n0 = c0 >> 2, j0 = c0 & 3, n1 = c1 >> 2, j1 = c1 & 3;
                    const float h0 = acc[ai][0][m][n0][j0] + acc[ai][1][m][n0][j0] * eh[c0], h1 = acc[ai][0][m][n1][j1] + acc[ai][1][m][n1][j1] * eh[c1];
                    float m0 = bf_lo(yw[q]) + h0 * bf_lo(gw4[q]), m1 = bf_hi(yw[q]) + h1 * bf_hi(gw4[q]);
                    ow[q] = cvt_pk_bf16(m0, m1);
                }
                *(u32x4*)((char*)MERGED + off) = (u32x4){ow[0], ow[1], ow[2], ow[3]};
            }
            if (half == 0) {
#pragma unroll
                for (int i = 0; i < 4; ++i) { qy[i] = ny[i]; qg[i] = ng[i]; }
            }
        }
    }
};
struct EpiGU {
    bf16_t* ACT;
    __device__ __forceinline__ void operator()(const f32x4 (&acc)[2][2][4][2], const pg8::Unit& u, int wr, int wc, int fr, int fq) const {
        const int row0 = u.pm * 256 + wr * 64 + fr, ch = u.pn * 128 + wc * 32 + fq * 8;
#pragma unroll
        for (int ai = 0; ai < 2; ++ai)
#pragma unroll
            for (int m = 0; m < 4; ++m) {
                const size_t off = (size_t)(row0 + ai * 128 + m * 16) * FF + ch;
                float v[8];
#pragma unroll
                for (int n = 0; n < 2; ++n)
#pragma unroll
                    for (int j = 0; j < 4; ++j) { const float g = acc[ai][0][m][n][j]; v[4 * n + j] = g * sigm(g) * acc[ai][1][m][n][j]; }
                u32x4 w; w.x = cvt_pk_bf16(v[0], v[1]); w.y = cvt_pk_bf16(v[2], v[3]); w.z = cvt_pk_bf16(v[4], v[5]); w.w = cvt_pk_bf16(v[6], v[7]);
                *(u32x4*)(ACT + off) = w;
            }
    }
};

__device__ __forceinline__ int map_in(int n) {
    const int q = n >> 10, ch = n & 1023;
    if (q == 3) return 6144 + (ch & ~127) + slot8(ch & 127);
    if (q == 4 || q == 6) return 4096 + (ch >> 7) * 256 + (q == 6 ? 128 : 0) + slot8(ch & 127);
    const int s = (q == 5) ? 3 : q;
    return (ch >> 6) * 256 + 128 * (s >> 1) + 32 * ((ch >> 4) & 3) + 16 * (s & 1) + (ch & 15);
}
__device__ __forceinline__ int map_gu(int n) { const int s = n >= FF ? 1 : 0, ch = n - s * FF; return (ch >> 7) * 256 + 128 * s + slot8(ch & 127); }
__device__ __forceinline__ int map_rg(int h, int s, int jc) { return (2 * h + (jc >> 7)) * 256 + 128 * s + slot8(jc & 127); }

__device__ __forceinline__ void tr_item(const float* src, int ldn, int k0, int n0, bf16_t* dst, int ldk, LAS float* scr, int lane, int kind, int aux) {
    float tv[32];
#pragma unroll
    for (int i = 0; i < 32; ++i) { const int kk = 2 * i + (lane >> 5); tv[i] = src[(size_t)(k0 + kk) * ldn + n0 + (lane & 31)]; }
#pragma unroll
    for (int i = 0; i < 32; ++i) { const int kk = 2 * i + (lane >> 5); scr[kk * 33 + (lane & 31)] = tv[i]; }
    asm volatile("s_waitcnt lgkmcnt(0)" ::: "memory");
    const int kp = lane & 31;
#pragma unroll 4
    for (int i = 0; i < 16; ++i) {
        const int jn = 2 * i + (lane >> 5), n = n0 + jn;
        const float v0 = scr[(2 * kp) * 33 + jn], v1 = scr[(2 * kp + 1) * 33 + jn];
        int row;
        if (kind == 0) row = map_in(n); else if (kind == 1) row = map_gu(n); else if (kind == 2) row = (n & ~127) | slot8(n & 127); else row = map_rg(aux >> 1, aux & 1, n);
        *(unsigned*)(dst + (size_t)row * ldk + k0 + 2 * kp) = cvt_pk_bf16(v0, v1);
    }
    asm volatile("s_waitcnt lgkmcnt(0)" ::: "memory");
}

__device__ __forceinline__ void norm_rows_bf16(const float* X, const float* g, const float* mod, int shoff, int scoff, bf16_t* H, int gw, int NGW, int lane) {
    for (int row = gw; row < M; row += NGW) {
        const float* mb = mod + (size_t)(row >> 13) * NMOD;
        const f32x4* xr = (const f32x4*)(X + (size_t)row * D) + lane;
        f32x4 v[4]; float s = 0.f;
#pragma unroll
        for (int j = 0; j < 4; ++j) { v[j] = xr[64 * j]; s += (v[j].x * v[j].x + v[j].y * v[j].y) + (v[j].z * v[j].z + v[j].w * v[j].w); }
        const float rstd = rsqrtf(wave_sum(s) * (1.0f / D) + EPS);
        u32x2* o = (u32x2*)(H + (size_t)row * D) + lane;
#pragma unroll
        for (int j = 0; j < 4; ++j) {
            const int col = 4 * (lane + 64 * j);
            const f32x4 g4 = *(const f32x4*)(g + col), sc4 = *(const f32x4*)(mb + scoff + col), sh4 = *(const f32x4*)(mb + shoff + col);
            const f32x4 y = v[j] * rstd * g4 * (sc4 + 1.0f) + sh4;
            u32x2 w; w.x = cvt_pk_bf16(y.x, y.y); w.y = cvt_pk_bf16(y.z, y.w); o[64 * j] = w;
        }
    }
}


__device__ __forceinline__ void amax_item(const float* src, int ldn, int k0, int n0, unsigned* cmax, int lane) {
    float mx = 0.f;
#pragma unroll
    for (int i = 0; i < 32; ++i) { const int kk = 2 * i + (lane >> 5); mx = fmaxf(mx, fabsf(src[(size_t)(k0 + kk) * ldn + n0 + (lane & 31)])); }
    mx = fmaxf(mx, __shfl_xor(mx, 32));
    if (lane < 32) (void)__hip_atomic_fetch_max(cmax + n0 + lane, __float_as_uint(mx), __ATOMIC_RELAXED, __HIP_MEMORY_SCOPE_AGENT);
}
__device__ __forceinline__ void q_item(const float* src, int ldn, int k0, int n0, signed char* dst, int ldk, unsigned* cmax, float* sb, LAS float* scr, int lane, int kind) {
    float tv[32];
#pragma unroll
    for (int i = 0; i < 32; ++i) { const int kk = 2 * i + (lane >> 5); tv[i] = src[(size_t)(k0 + kk) * ldn + n0 + (lane & 31)]; }
#pragma unroll
    for (int i = 0; i < 32; ++i) { const int kk = 2 * i + (lane >> 5); scr[kk * 33 + (lane & 31)] = tv[i]; }
    asm volatile("s_waitcnt lgkmcnt(0)" ::: "memory");
    const int kq = lane & 15;
#pragma unroll 2
    for (int i = 0; i < 8; ++i) {
        const int jn = 4 * i + (lane >> 4), n = n0 + jn;
        const float cm = __uint_as_float(__hip_atomic_load(cmax + n, __ATOMIC_RELAXED, __HIP_MEMORY_SCOPE_AGENT));
        const float inv = cm > 0.f ? 127.0f / cm : 0.f;
        const int q0 = (int)__builtin_rintf(scr[(4 * kq + 0) * 33 + jn] * inv), q1 = (int)__builtin_rintf(scr[(4 * kq + 1) * 33 + jn] * inv),
                  q2 = (int)__builtin_rintf(scr[(4 * kq + 2) * 33 + jn] * inv), q3 = (int)__builtin_rintf(scr[(4 * kq + 3) * 33 + jn] * inv);
        const int row = (kind == 0) ? map_in(n) : (kind == 1 ? map_gu(n) : map_in(n) - 4096);
        *(unsigned*)(dst + (size_t)row * ldk + k0 + 4 * kq) = (unsigned)(q0 & 0xff) | ((unsigned)(q1 & 0xff) << 8) | ((unsigned)(q2 & 0xff) << 16) | ((unsigned)q3 << 24);
        if (k0 == 0 && kq == 0) sb[row] = cm * (1.0f / 127.0f);
    }
    asm volatile("s_waitcnt lgkmcnt(0)" ::: "memory");
}
__device__ __forceinline__ float wave_max(float v) {
#pragma unroll
    for (int o = 32; o >= 1; o >>= 1) v = fmaxf(v, __shfl_xor(v, o));
    return v;
}
__device__ __forceinline__ void norm_rows_i8(const float* X, const float* g, const float* mod, int shoff, int scoff, signed char* Hq, float* sa, bf16_t* Hb, int gw, int NGW, int lane) {
    f32x4 nv[4];
    if (gw < M) { const f32x4* xr = (const f32x4*)(X + (size_t)gw * D) + lane;
#pragma unroll
        for (int j = 0; j < 4; ++j) nv[j] = xr[64 * j]; }
    int cur_b = -1; f32x4 gs[4], shv[4];
    for (int row = gw; row < M; row += NGW) {
        f32x4 v[4]; float s = 0.f;
#pragma unroll
        for (int j = 0; j < 4; ++j) { v[j] = nv[j]; s += (v[j].x * v[j].x + v[j].y * v[j].y) + (v[j].z * v[j].z + v[j].w * v[j].w); }
        if (row + NGW < M) { const f32x4* xr = (const f32x4*)(X + (size_t)(row + NGW) * D) + lane;
#pragma unroll
            for (int j = 0; j < 4; ++j) nv[j] = xr[64 * j]; }
        const int b = row >> 13;
        if (b != cur_b) { cur_b = b; const float* mb = mod + (size_t)b * NMOD;
#pragma unroll
            for (int j = 0; j < 4; ++j) { const int col = 4 * (lane + 64 * j); gs[j] = *(const f32x4*)(g + col) * (*(const f32x4*)(mb + scoff + col) + 1.0f); shv[j] = *(const f32x4*)(mb + shoff + col); } }
        const float rstd = rsqrtf(wave_sum(s) * (1.0f / D) + EPS);
        float mx = 0.f;
#pragma unroll
        for (int j = 0; j < 4; ++j) {
            v[j] = v[j] * rstd * gs[j] + shv[j];
            mx = fmaxf(mx, fmaxf(fmaxf(fabsf(v[j].x), fabsf(v[j].y)), fmaxf(fabsf(v[j].z), fabsf(v[j].w))));
        }
        mx = wave_max(mx);
        const float inv = mx > 0.f ? 127.0f / mx : 0.f;
        unsigned* o = (unsigned*)(Hq + (size_t)row * D) + lane;
#pragma unroll
        for (int j = 0; j < 4; ++j) {
            const int q0 = (int)__builtin_rintf(v[j].x * inv), q1 = (int)__builtin_rintf(v[j].y * inv), q2 = (int)__builtin_rintf(v[j].z * inv), q3 = (int)__builtin_rintf(v[j].w * inv);
            o[64 * j] = (unsigned)(q0 & 0xff) | ((unsigned)(q1 & 0xff) << 8) | ((unsigned)(q2 & 0xff) << 16) | ((unsigned)q3 << 24);
            if (Hb) { u32x2 w; w.x = cvt_pk_bf16(v[j].x, v[j].y); w.y = cvt_pk_bf16(v[j].z, v[j].w); ((u32x2*)(Hb + (size_t)row * D) + lane)[64 * j] = w; }
        }
        if (lane == 0) sa[row] = mx * (1.0f / 127.0f);
    }
}

__device__ __forceinline__ void conv_fix_item(int hb, int c8, bool doU, bool doYA, const float* conv_b_w, const float* conv_b_bias, const float* conv_a_w, const bf16_t* RXS, bf16_t* U, bf16_t* YA, const bf16_t* PT, const bf16_t* ST) {
    const int t0 = hb * 128;
    if (doU) {
        u32x4 x[6];
#pragma unroll
        for (int k = 0; k < 3; ++k) { x[k] = *(const u32x4*)(RXS + (size_t)((hb - 1) * 6 + 3 + k) * D + c8); x[3 + k] = *(const u32x4*)(RXS + (size_t)(hb * 6 + k) * D + c8); }
        float w[4][8], bb[8];
#pragma unroll
        for (int k = 0; k < 4; ++k)
#pragma unroll
            for (int j = 0; j < 8; ++j) w[k][j] = conv_b_w[k * D + c8 + j];
#pragma unroll
        for (int j = 0; j < 8; ++j) bb[j] = conv_b_bias[c8 + j];
#pragma unroll
        for (int o = 0; o < 3; ++o) {
            float v[8];
#pragma unroll
            for (int j = 0; j < 8; ++j) v[j] = bb[j];
#pragma unroll
            for (int k = 0; k < 4; ++k) { const u32x4 q = x[o + k];
                v[0] += w[k][0] * bf_lo(q.x); v[1] += w[k][1] * bf_hi(q.x); v[2] += w[k][2] * bf_lo(q.y); v[3] += w[k][3] * bf_hi(q.y);
                v[4] += w[k][4] * bf_lo(q.z); v[5] += w[k][5] * bf_hi(q.z); v[6] += w[k][6] * bf_lo(q.w); v[7] += w[k][7] * bf_hi(q.w); }
            u32x4 wv; wv.x = cvt_pk_bf16(v[0], v[1]); wv.y = cvt_pk_bf16(v[2], v[3]); wv.z = cvt_pk_bf16(v[4], v[5]); wv.w = cvt_pk_bf16(v[6], v[7]);
            *(u32x4*)(U + (size_t)(t0 + o) * D + c8) = wv;
        }
    }
    if (doYA) {
        const u32x4 s0 = *(const u32x4*)(ST + (size_t)(hb * 2 + 0) * D + c8), s1 = *(const u32x4*)(ST + (size_t)(hb * 2 + 1) * D + c8);
        const u32x4 pa = *(const u32x4*)(PT + (size_t)((hb - 1) * 2 + 0) * D + c8), pb = *(const u32x4*)(PT + (size_t)((hb - 1) * 2 + 1) * D + c8);
        const u32x4 y0 = *(const u32x4*)(YA + (size_t)t0 * D + c8), y1 = *(const u32x4*)(YA + (size_t)(t0 + 1) * D + c8);
        const unsigned s0w[4] = {s0.x, s0.y, s0.z, s0.w}, s1w[4] = {s1.x, s1.y, s1.z, s1.w}, paw[4] = {pa.x, pa.y, pa.z, pa.w}, pbw[4] = {pb.x, pb.y, pb.z, pb.w}, y0w[4] = {y0.x, y0.y, y0.z, y0.w}, y1w[4] = {y1.x, y1.y, y1.z, y1.w};
        unsigned o0[4], o1[4];
#pragma unroll
        for (int q = 0; q < 4; ++q) {
            const int j0 = 2 * q, j1 = 2 * q + 1;
            const float w00 = conv_a_w[c8 + j0], w01 = conv_a_w[c8 + j1], w10 = conv_a_w[D + c8 + j0], w11 = conv_a_w[D + c8 + j1];
            o0[q] = cvt_pk_bf16(bf_lo(y0w[q]) + bf_lo(s0w[q]) * (w00 * bf_lo(paw[q]) + w10 * bf_lo(pbw[q])), bf_hi(y0w[q]) + bf_hi(s0w[q]) * (w01 * bf_hi(paw[q]) + w11 * bf_hi(pbw[q])));
            o1[q] = cvt_pk_bf16(bf_lo(y1w[q]) + bf_lo(s1w[q]) * (w00 * bf_lo(pbw[q])), bf_hi(y1w[q]) + bf_hi(s1w[q]) * (w01 * bf_hi(pbw[q])));
        }
        *(u32x4*)(YA + (size_t)t0 * D + c8) = (u32x4){o0[0], o0[1], o0[2], o0[3]}; *(u32x4*)(YA + (size_t)(t0 + 1) * D + c8) = (u32x4){o1[0], o1[1], o1[2], o1[3]};
    }
}

struct Params { const float* in[19]; float* out; unsigned char* ws; };

__global__ void __launch_bounds__(512, 2) fwd_megakernel(Params P) {
    extern __shared__ __attribute__((aligned(16))) unsigned char lds_raw[];
    LAS unsigned char* lds = (LAS unsigned char*)lds_raw;
    cg::grid_group grid = cg::this_grid();
    const int G = gridDim.x, bid = blockIdx.x;
    const int cid = (G == 256) ? ((bid & 31) * 8 + (bid >> 5)) : bid;
#define KARG(i) ({ const __attribute__((address_space(4))) char* _k = (const __attribute__((address_space(4))) char*)__builtin_amdgcn_kernarg_segment_ptr(); asm volatile("" : "+s"(_k)); *(const float* const __attribute__((address_space(4)))*)(_k + 8 * (i)); })
#define PHASE_IDS() int tid = threadIdx.x; asm volatile("" : "+v"(tid)); const int lane = tid & 63, wave = __builtin_amdgcn_readfirstlane(tid >> 6), gw = bid * 8 + wave, NGW = G * 8; (void)lane; (void)gw; (void)NGW
#define WSP(T, off) ((T*)((unsigned char*)KARG(20) + (off)))
#define OUTP ((float*)KARG(19))
#define GRID_BAR() do { XcdBarrier _b; _b.bar = WSP(unsigned, WS_BAR); _b.x = xb_xcc_id(); _b.st = (volatile LAS unsigned*)(lds + 131072); xcd_barrier(_b); } while (0)
    if (threadIdx.x < 4) ((LAS unsigned*)(lds + 131072))[threadIdx.x] = 0u;
    __syncthreads();
    xcd_barrier_post(WSP(unsigned, WS_BAR));
    for (int pass = 0; pass < NPASS; ++pass) {
    for (int rep = 0; rep < REP0; ++rep)
    {
        PHASE_IDS();
        const float* c = KARG(1); const float* w_ada = KARG(2); const float* b_ada = KARG(3); const float* lam = KARG(13);
        float* MOD = WSP(float, WS_MOD); float* LS8 = WSP(float, WS_LS8);
        LAS float* scl = (LAS float*)(lds + 98304);
        LAS float* red = (LAS float*)(lds + 98304 + 16384);
        for (int i = tid; i < 4096; i += 512) { const float v = c[i]; scl[i] = v / (1.0f + __expf(-v)); }
        __syncthreads();
        if (bid == G - 1) for (int i = tid; i < D; i += 512) LS8[i] = -8.0f * log1pf(expf(-lam[i]));
        LAS float* scr = (LAS float*)(lds + wave * 8448);
        constexpr int B_MOD = NMOD / 32, B_IN = 16 * (NIN / 256), B_GU = 16 * (NGU / 256), B_DN = (FF / 64) * (D / 256), B_OUT = 16 * (D / 256), B_RG = 2 * 4 * 4;
        for (int bi = bid; bi < B_MOD + B_IN + B_GU + B_DN + B_OUT + B_RG; bi += G) {
            int r = bi;
            if (r < B_MOD) {
                const int col = lane & 31, n = r * 32 + col, k0 = wave * 128 + (lane >> 5);
                float a0 = 0.f, a1 = 0.f, a2 = 0.f, a3 = 0.f;
#pragma unroll 16
                for (int k = 0; k < 128; k += 2) { const float w = w_ada[(size_t)(k0 + k) * NMOD + n]; a0 += scl[k0 + k] * w; a1 += scl[1024 + k0 + k] * w; a2 += scl[2048 + k0 + k] * w; a3 += scl[3072 + k0 + k] * w; }
                a0 += __shfl_xor(a0, 32); a1 += __shfl_xor(a1, 32); a2 += __shfl_xor(a2, 32); a3 += __shfl_xor(a3, 32);
                __syncthreads();
                if (lane < 32) { red[(wave * 4 + 0) * 32 + col] = a0; red[(wave * 4 + 1) * 32 + col] = a1; red[(wave * 4 + 2) * 32 + col] = a2; red[(wave * 4 + 3) * 32 + col] = a3; }
                __syncthreads();
                if (tid < 128) { const int b = tid >> 5; float s = b_ada[r * 32 + col];
#pragma unroll
                    for (int w = 0; w < 8; ++w) s += red[(w * 4 + b) * 32 + col];
                    MOD[(size_t)b * NMOD + r * 32 + col] = s; }
                continue;
            }
            r -= B_MOD;
            if (r < B_IN) { const int part = r >> 6;
                            const bool i8 = (P2_I8 == 1) || (P2_I8 == 2 && (part == 3 || part == 4 || part == 6));
                            if (i8) amax_item(KARG(5), NIN, (r & 15) * 64, ((r >> 4) * 8 + wave) * 32, WSP(unsigned, WS_CMAXIN), lane);
                            else tr_item(KARG(5), NIN, (r & 15) * 64, ((r >> 4) * 8 + wave) * 32, WSP(bf16_t, WS_WIN), D, scr, lane, 0, 0); continue; } r -= B_IN;
            if (r < B_GU) { if (P10_I8) amax_item(KARG(16), NGU, (r & 15) * 64, ((r >> 4) * 8 + wave) * 32, WSP(unsigned, WS_CMAXGU), lane);
                            else tr_item(KARG(16), NGU, (r & 15) * 64, ((r >> 4) * 8 + wave) * 32, WSP(bf16_t, WS_WGU), D, scr, lane, 1, 0); continue; } r -= B_GU;
            if (r < B_DN) { tr_item(KARG(17), D, (r % 44) * 64, ((r / 44) * 8 + wave) * 32, WSP(bf16_t, WS_WDN), FF, scr, lane, 2, 0); continue; } r -= B_DN;
            if (r < B_OUT) { tr_item(KARG(14), D, (r & 15) * 64, ((r >> 4) * 8 + wave) * 32, WSP(bf16_t, WS_WOUT), D, scr, lane, 2, 0); continue; } r -= B_OUT;
            { const int sx = r >> 4, h = (r >> 2) & 3, kt = r & 3;
              tr_item((sx ? KARG(11) : KARG(9)) + (size_t)h * 65536, 256, kt * 64, wave * 32, WSP(bf16_t, WS_WRG), 256, scr, lane, 3, h * 2 + sx); }
        }
    }
    if (gridDim.x > 65536u) grid.sync();
    GRID_BAR();
    for (int rep = 0; rep < REP1; ++rep)
    { PHASE_IDS();
      { LAS float* scr = (LAS float*)(lds + wave * 8448);
        constexpr int Q_IN = P2_I8 == 1 ? 16 * (NIN / 256) : (P2_I8 == 2 ? 16 * 12 : 0), Q_GU = P10_I8 ? 16 * (NGU / 256) : 0;
        for (int r0 = bid; r0 < Q_IN + Q_GU; r0 += G) {
            int r = r0;
            if (r < Q_IN) {
                if (P2_I8 == 1) q_item(KARG(5), NIN, (r & 15) * 64, ((r >> 4) * 8 + wave) * 32, WSP(signed char, WS_WIN), D, WSP(unsigned, WS_CMAXIN), WSP(float, WS_SBIN), scr, lane, 0);
                else { const int j = r >> 4, part = (j >> 2) == 0 ? 3 : ((j >> 2) == 1 ? 4 : 6), ng = part * 4 + (j & 3);
                       q_item(KARG(5), NIN, (r & 15) * 64, (ng * 8 + wave) * 32, WSP(signed char, WS_WIN + 8 * MiB), D, WSP(unsigned, WS_CMAXIN), WSP(float, WS_SBIN), scr, lane, 2); }
                continue; }
            r -= Q_IN;
            q_item(KARG(16), NGU, (r & 15) * 64, ((r >> 4) * 8 + wave) * 32, WSP(signed char, WS_WGU), D, WSP(unsigned, WS_CMAXGU), WSP(float, WS_SBGU), scr, lane, 1);
        }
        if (P10_I8 && bid == G - 1 && wave < 4) {
            const float* shp = WSP(float, WS_MOD) + (size_t)wave * NMOD + 3072; float mx = 0.f;
            for (int i = lane; i < D; i += 64) mx = fmaxf(mx, fabsf(shp[i]));
            mx = wave_max(mx); if (lane == 0) WSP(float, WS_SHMAX)[wave] = mx; } }
      if (P2_I8 == 1) norm_rows_i8(KARG(0), KARG(4), WSP(float, WS_MOD), 0, 1024, WSP(signed char, WS_H), WSP(float, WS_SA1), nullptr, gw, NGW, lane);
      else if (P2_I8 == 2) norm_rows_i8(KARG(0), KARG(4), WSP(float, WS_MOD), 0, 1024, (signed char*)OUTP, WSP(float, WS_SA1), WSP(bf16_t, WS_H), gw, NGW, lane);
      else norm_rows_bf16(KARG(0), KARG(4), WSP(float, WS_MOD), 0, 1024, WSP(bf16_t, WS_H), gw, NGW, lane); }
    GRID_BAR();
    for (int rep = 0; rep < REP2; ++rep)
    if (P2_I8 == 1) { pg8::GemmI8 g{WSP(signed char, WS_H), WSP(signed char, WS_WIN), M, NIN, D, D, D}; pg8::StaticOrder S; S.init(M, NIN, G, cid);
      EpiI8<Epi1> E{WSP(float, WS_SA1), WSP(float, WS_SBIN), Epi1{WSP(bf16_t, WS_SA), WSP(bf16_t, WS_P), WSP(bf16_t, WS_G2), WSP(bf16_t, WS_RX)}, 0}; pg8::gemm_phase_i8(lds, g, S, E); }
    else if (P2_I8 == 2) {
      if (CONV3_FUSED) { pg8::Gemm g{WSP(bf16_t, WS_H), WSP(bf16_t, WS_WIN), M, 4096, D, D, D, -1}; pg8::StaticOrder S; S.init(M, 4096, G, cid);
        EpiConvA E{WSP(bf16_t, WS_SA), WSP(bf16_t, WS_P), WSP(bf16_t, WS_P + 1 * MiB), KARG(6)}; pg8::gemm_phase<EpiConvA, true>(lds, g, S, E); }
      else { pg8::Gemm g{WSP(bf16_t, WS_H), WSP(bf16_t, WS_WIN), M, 4096, D, D, D, -1}; pg8::StaticOrder S; S.init(M, 4096, G, cid);
        Epi1 E{WSP(bf16_t, WS_SA), WSP(bf16_t, WS_P), WSP(bf16_t, WS_G2), WSP(bf16_t, WS_RX)}; pg8::gemm_phase(lds, g, S, E); }
      if (CONV4_FUSED) {
        { pg8::GemmI8 g{(const signed char*)OUTP, WSP(signed char, WS_WIN + 8 * MiB), M, 2048, D, D, D}; pg8::StaticOrder S; S.init(M, 2048, G, cid);
          EpiI8<Epi1> E{WSP(float, WS_SA1), WSP(float, WS_SBIN), Epi1{WSP(bf16_t, WS_SA), WSP(bf16_t, WS_P), WSP(bf16_t, WS_G2), WSP(bf16_t, WS_RX)}, 16}; pg8::gemm_phase_i8(lds, g, S, E); }
        { pg8::GemmI8 g{(const signed char*)OUTP, WSP(signed char, WS_WIN + 10 * MiB), M, 1024, D, D, D}; pg8::StaticOrder S; S.init(M, 1024, G, cid);
          EpiConvC E{WSP(float, WS_SA1), WSP(float, WS_SBIN) + 2048, WSP(bf16_t, WS_RX), WSP(bf16_t, WS_P + 2 * MiB), KARG(7), KARG(8)}; pg8::gemm_phase_i8<EpiConvC, true>(lds, g, S, E); } }
      else { pg8::GemmI8 g{(const signed char*)OUTP, WSP(signed char, WS_WIN + 8 * MiB), M, 3072, D, D, D}; pg8::StaticOrder S; S.init(M, 3072, G, cid);
        EpiI8<Epi1> E{WSP(float, WS_SA1), WSP(float, WS_SBIN), Epi1{WSP(bf16_t, WS_SA), WSP(bf16_t, WS_P), WSP(bf16_t, WS_G2), WSP(bf16_t, WS_RX)}, 16}; pg8::gemm_phase_i8(lds, g, S, E); } }
    else { pg8::Gemm g{WSP(bf16_t, WS_H), WSP(bf16_t, WS_WIN), M, NIN, D, D, D, -1}; pg8::StaticOrder S; S.init(M, NIN, G, cid);
      Epi1 E{WSP(bf16_t, WS_SA), WSP(bf16_t, WS_P), WSP(bf16_t, WS_G2), WSP(bf16_t, WS_RX)}; pg8::gemm_phase(lds, g, S, E); }
    GRID_BAR();
    if (CONV4_FUSED && P2_I8 == 2 && SCAN_FUSED && FIX_IN_P4) { }
    else if (CONV4_FUSED && P2_I8 == 2) {
        PHASE_IDS();
        const int gt = bid * 512 + tid;
        if (gt < (M / 128) * 128) {
            const int hb = gt >> 7, c8 = (gt & 127) * 8;
            if (((hb * 128) & (SEQ - 1)) != 0)
                conv_fix_item(hb, c8, true, SCAN_FUSED != 0, KARG(7), KARG(8), KARG(6), WSP(bf16_t, WS_P + 2 * MiB), WSP(bf16_t, WS_RX), WSP(bf16_t, WS_SA), WSP(bf16_t, WS_P), WSP(bf16_t, WS_P + 1 * MiB));
        }
    } else
    for (int rep = 0; rep < REP3; ++rep)
    {
        PHASE_IDS();
        const float* conv_b_w = KARG(7); const float* conv_b_bias = KARG(8); const bf16_t* RX = WSP(bf16_t, WS_RX); bf16_t* U = WSP(bf16_t, WS_H);
        const int c8 = (tid & 127) * 8, tq = tid >> 7;
        float w[4][8], bb[8];
#pragma unroll
        for (int k = 0; k < 4; ++k)
#pragma unroll
            for (int j = 0; j < 8; ++j) w[k][j] = conv_b_w[k * D + c8 + j];
#pragma unroll
        for (int j = 0; j < 8; ++j) bb[j] = conv_b_bias[c8 + j];
        for (int it = bid; it < M / 16; it += G) {
            const int t0 = it * 16 + tq * 4, tb = t0 & (SEQ - 1);
            u32x4 r[7];
#pragma unroll
            for (int i = 0; i < 7; ++i) { r[i] = (u32x4){0u, 0u, 0u, 0u}; if (tb - 3 + i >= 0) r[i] = *(const u32x4*)(RX + (size_t)(t0 - 3 + i) * D + c8); }
#pragma unroll
            for (int o = 0; o < 4; ++o) {
                float v[8];
#pragma unroll
                for (int j = 0; j < 8; ++j) v[j] = bb[j];
#pragma unroll
                for (int k = 0; k < 4; ++k) { const u32x4 q = r[o + k];
                    v[0] += w[k][0] * bf_lo(q.x); v[1] += w[k][1] * bf_hi(q.x); v[2] += w[k][2] * bf_lo(q.y); v[3] += w[k][3] * bf_hi(q.y);
                    v[4] += w[k][4] * bf_lo(q.z); v[5] += w[k][5] * bf_hi(q.z); v[6] += w[k][6] * bf_lo(q.w); v[7] += w[k][7] * bf_hi(q.w); }
                u32x4 wv; wv.x = cvt_pk_bf16(v[0], v[1]); wv.y = cvt_pk_bf16(v[2], v[3]); wv.z = cvt_pk_bf16(v[4], v[5]); wv.w = cvt_pk_bf16(v[6], v[7]);
                *(u32x4*)(U + (size_t)(t0 + o) * D + c8) = wv;
            }
        }
    }
    if (!(CONV4_FUSED && P2_I8 == 2 && SCAN_FUSED && FIX_IN_P4)) GRID_BAR();
    if (SCAN_FUSED) {
      if (FIX_IN_P4) {
        PHASE_IDS();
        pg8::StaticOrder S0; S0.init(M, 2048, G, cid); S0.chain = 1;
        if (tid < 256) {
            const int r = tid >> 6, hh = (tid >> 5) & 1, k = tid & 31; pg8::Unit u0;
            if (S0.next(r, u0)) { const int hb = 2 * u0.pm + hh, c8 = (u0.pn >> 1) * 256 + k * 8;
                if (((hb * 128) & (SEQ - 1)) != 0)
                    conv_fix_item(hb, c8, true, (c8 >> 7) == u0.pn, KARG(7), KARG(8), KARG(6), WSP(bf16_t, WS_P + 2 * MiB), WSP(bf16_t, WS_RX), WSP(bf16_t, WS_SA), WSP(bf16_t, WS_P), WSP(bf16_t, WS_P + 1 * MiB)); }
        }
        asm volatile("s_waitcnt vmcnt(0)" ::: "memory"); __syncthreads();
      }
      pg8::Gemm g{WSP(bf16_t, WS_RX), WSP(bf16_t, WS_WRG), M, 2048, 256, D, 256, 1}; pg8::StaticOrder S; S.init(M, 2048, G, cid); S.chain = 1;
      EpiRG3 E{WSP(bf16_t, WS_RX), WSP(bf16_t, WS_H), WSP(unsigned long long, WS_TOT), WSP(unsigned, WS_FLAG), KARG(10), KARG(12), WSP(float, WS_LS8), (LAS float*)(lds + LDS_XCH),
               WSP(bf16_t, WS_SA), WSP(bf16_t, WS_G2), WSP(bf16_t, WS_P), WSP(bf16_t, WS_P + 1 * MiB), KARG(6)};
      pg8::gemm_phase<EpiRG3, true>(lds, g, S, E); }
    else
    for (int rep = 0; rep < REP4; ++rep)
    { constexpr size_t WS_U = (CONV4_FUSED && P2_I8 == 2) ? WS_RX : WS_H;
      pg8::Gemm g{WSP(bf16_t, WS_U), WSP(bf16_t, WS_WRG), M, 2048, 256, D, 256, 1}; pg8::StaticOrder S; S.init(M, 2048, G, cid);
      EpiRG2 E{WSP(bf16_t, WS_U), WSP(bf16_t, WS_BX), WSP(bf16_t, WS_BX + 64 * MiB), WSP(float, WS_APROD), WSP(float, WS_HEND), KARG(10), KARG(12), WSP(float, WS_LS8), (LAS float*)(lds + LDS_XCH)};
      pg8::gemm_phase<EpiRG2, true>(lds, g, S, E); }
    GRID_BAR();
    if (SCAN_FUSED) {   } else
    if (CONV3_FUSED) {
        PHASE_IDS();
        const float* conv_a_w = KARG(6); const float* AT = WSP(float, WS_APROD); const float* HT = WSP(float, WS_HEND);
        const bf16_t* HL = WSP(bf16_t, WS_BX); const bf16_t* PC = WSP(bf16_t, WS_BX + 64 * MiB);
        const bf16_t* YA = WSP(bf16_t, WS_SA); const bf16_t* PT = WSP(bf16_t, WS_P); const bf16_t* ST = WSP(bf16_t, WS_P + 1 * MiB); const bf16_t* G2 = WSP(bf16_t, WS_G2); bf16_t* MERGED = WSP(bf16_t, WS_RX);
        const int c8 = (tid & 127) * 8, tq = tid >> 7;
        float w0[8], w1[8];
#pragma unroll
        for (int j = 0; j < 8; ++j) { w0[j] = conv_a_w[c8 + j]; w1[j] = conv_a_w[D + c8 + j]; }
        for (int it = bid; it < M / 64; it += G) {
            const int pm = it >> 2, kb = pm & 31;
            float cy[8];
#pragma unroll
            for (int j = 0; j < 8; ++j) cy[j] = 0.f;
#pragma unroll 4
            for (int k = pm - kb; k < pm; ++k) {
                const f32x4 a0 = *(const f32x4*)(AT + (size_t)k * D + c8), a1 = *(const f32x4*)(AT + (size_t)k * D + c8 + 4), h0 = *(const f32x4*)(HT + (size_t)k * D + c8), h1 = *(const f32x4*)(HT + (size_t)k * D + c8 + 4);
#pragma unroll
                for (int j = 0; j < 4; ++j) { cy[j] = a0[j] * cy[j] + h0[j]; cy[4 + j] = a1[j] * cy[4 + j] + h1[j]; }
            }
            const int t0 = it * 64 + tq * 16;
            float fx0[8], fx1[8];
#pragma unroll
            for (int j = 0; j < 8; ++j) { fx0[j] = 0.f; fx1[j] = 0.f; }
            if ((t0 & 127) == 0 && (t0 & (SEQ - 1)) != 0) {
                const int hb = t0 >> 7;
                const u32x4 s0 = *(const u32x4*)(ST + (size_t)(hb * 2 + 0) * D + c8), s1 = *(const u32x4*)(ST + (size_t)(hb * 2 + 1) * D + c8);
                const u32x4 pa = *(const u32x4*)(PT + (size_t)((hb - 1) * 2 + 0) * D + c8), pb = *(const u32x4*)(PT + (size_t)((hb - 1) * 2 + 1) * D + c8);
                const unsigned s0w[4] = {s0.x, s0.y, s0.z, s0.w}, s1w[4] = {s1.x, s1.y, s1.z, s1.w}, paw[4] = {pa.x, pa.y, pa.z, pa.w}, pbw[4] = {pb.x, pb.y, pb.z, pb.w};
#pragma unroll
                for (int q = 0; q < 4; ++q) {
                    const int j0 = 2 * q, j1 = 2 * q + 1;
                    fx0[j0] = bf_lo(s0w[q]) * (w0[j0] * bf_lo(paw[q]) + w1[j0] * bf_lo(pbw[q])); fx0[j1] = bf_hi(s0w[q]) * (w0[j1] * bf_hi(paw[q]) + w1[j1] * bf_hi(pbw[q]));
                    fx1[j0] = bf_lo(s1w[q]) * (w0[j0] * bf_lo(pbw[q]));                            fx1[j1] = bf_hi(s1w[q]) * (w0[j1] * bf_hi(pbw[q]));
                }
            }
            for (int tb = 0; tb < 16; tb += 4) {
                u32x4 qh[4], qc[4], qy[4], qg[4];
#pragma unroll
                for (int t = 0; t < 4; ++t) { const unsigned o = ((unsigned)(t0 + tb + t) * D + c8) * 2u; qh[t] = *(const u32x4*)((const char*)HL + o); qc[t] = *(const u32x4*)((const char*)PC + o); qy[t] = *(const u32x4*)((const char*)YA + o); qg[t] = *(const u32x4*)((const char*)G2 + o); }
#pragma unroll
                for (int t = 0; t < 4; ++t) {
                    const unsigned hw[4] = {qh[t].x, qh[t].y, qh[t].z, qh[t].w}, cw[4] = {qc[t].x, qc[t].y, qc[t].z, qc[t].w}, yw[4] = {qy[t].x, qy[t].y, qy[t].z, qy[t].w}, gw4[4] = {qg[t].x, qg[t].y, qg[t].z, qg[t].w};
                    unsigned ow[4];
#pragma unroll
                    for (int q = 0; q < 4; ++q) {
                        const int j0 = 2 * q, j1 = 2 * q + 1;
                        const float h0 = bf_lo(hw[q]) + bf_lo(cw[q]) * cy[j0], h1 = bf_hi(hw[q]) + bf_hi(cw[q]) * cy[j1];
                        float m0 = bf_lo(yw[q]) + h0 * bf_lo(gw4[q]), m1 = bf_hi(yw[q]) + h1 * bf_hi(gw4[q]);
                        if (tb == 0 && t == 0) { m0 += fx0[j0]; m1 += fx0[j1]; }
                        if (tb == 0 && t == 1) { m0 += fx1[j0]; m1 += fx1[j1]; }
                        ow[q] = cvt_pk_bf16(m0, m1);
                    }
                    *(u32x4*)((char*)MERGED + ((unsigned)(t0 + tb + t) * D + c8) * 2u) = (u32x4){ow[0], ow[1], ow[2], ow[3]};
                }
            }
        }
    } else
    for (int rep = 0; rep < REP7; ++rep)
    {
        PHASE_IDS();
        const float* conv_a_w = KARG(6); const float* AT = WSP(float, WS_APROD); const float* HT = WSP(float, WS_HEND);
        const bf16_t* HL = WSP(bf16_t, WS_BX); const bf16_t* PC = WSP(bf16_t, WS_BX + 64 * MiB);
        const bf16_t* PP = WSP(bf16_t, WS_P); const bf16_t* SA = WSP(bf16_t, WS_SA); const bf16_t* G2 = WSP(bf16_t, WS_G2); bf16_t* MERGED = WSP(bf16_t, WS_RX);
        const int c8 = (tid & 127) * 8, tq = tid >> 7;
        float w0[8], w1[8], w2[8];
#pragma unroll
        for (int j = 0; j < 8; ++j) { w0[j] = conv_a_w[c8 + j]; w1[j] = conv_a_w[D + c8 + j]; w2[j] = conv_a_w[2 * D + c8 + j]; }
        for (int it = bid; it < M / 64; it += G) {
            const int pm = it >> 2, kb = pm & 31;
            float cy[8];
#pragma unroll
            for (int j = 0; j < 8; ++j) cy[j] = 0.f;
#pragma unroll 4
            for (int k = pm - kb; k < pm; ++k) {
                const f32x4 a0 = *(const f32x4*)(AT + (size_t)k * D + c8), a1 = *(const f32x4*)(AT + (size_t)k * D + c8 + 4), h0 = *(const f32x4*)(HT + (size_t)k * D + c8), h1 = *(const f32x4*)(HT + (size_t)k * D + c8 + 4);
#pragma unroll
                for (int j = 0; j < 4; ++j) { cy[j] = a0[j] * cy[j] + h0[j]; cy[4 + j] = a1[j] * cy[4 + j] + h1[j]; }
            }
            const int t0 = it * 64 + tq * 16;
            float pm2[8], pm1[8];
            {
                u32x4 q2 = {0u, 0u, 0u, 0u}, q1 = {0u, 0u, 0u, 0u};
                if ((t0 & (SEQ - 1)) != 0) { q2 = *(const u32x4*)(PP + (size_t)(t0 - 2) * D + c8); q1 = *(const u32x4*)(PP + (size_t)(t0 - 1) * D + c8); }
                pm2[0] = bf_lo(q2.x); pm2[1] = bf_hi(q2.x); pm2[2] = bf_lo(q2.y); pm2[3] = bf_hi(q2.y); pm2[4] = bf_lo(q2.z); pm2[5] = bf_hi(q2.z); pm2[6] = bf_lo(q2.w); pm2[7] = bf_hi(q2.w);
                pm1[0] = bf_lo(q1.x); pm1[1] = bf_hi(q1.x); pm1[2] = bf_lo(q1.y); pm1[3] = bf_hi(q1.y); pm1[4] = bf_lo(q1.z); pm1[5] = bf_hi(q1.z); pm1[6] = bf_lo(q1.w); pm1[7] = bf_hi(q1.w);
            }
            for (int tb = 0; tb < 16; tb += 4) {
                u32x4 qh[4], qc[4], qp[4], qs[4], qg[4];
#pragma unroll
                for (int t = 0; t < 4; ++t) { const unsigned o = ((unsigned)(t0 + tb + t) * D + c8) * 2u; qh[t] = *(const u32x4*)((const char*)HL + o); qc[t] = *(const u32x4*)((const char*)PC + o); qp[t] = *(const u32x4*)((const char*)PP + o); qs[t] = *(const u32x4*)((const char*)SA + o); qg[t] = *(const u32x4*)((const char*)G2 + o); }
#pragma unroll
                for (int t = 0; t < 4; ++t) {
                    const unsigned hw[4] = {qh[t].x, qh[t].y, qh[t].z, qh[t].w}, cw[4] = {qc[t].x, qc[t].y, qc[t].z, qc[t].w}, pw[4] = {qp[t].x, qp[t].y, qp[t].z, qp[t].w},
                                   sw[4] = {qs[t].x, qs[t].y, qs[t].z, qs[t].w}, gw4[4] = {qg[t].x, qg[t].y, qg[t].z, qg[t].w};
                    unsigned ow[4];
#pragma unroll
                    for (int q = 0; q < 4; ++q) {
                        const int j0 = 2 * q, j1 = 2 * q + 1;
                        const float pc0 = bf_lo(pw[q]), pc1 = bf_hi(pw[q]);
                        const float h0 = bf_lo(hw[q]) + bf_lo(cw[q]) * cy[j0], h1 = bf_hi(hw[q]) + bf_hi(cw[q]) * cy[j1];
                        const float m0 = bf_lo(sw[q]) * (w0[j0] * pm2[j0] + w1[j0] * pm1[j0] + w2[j0] * pc0) + h0 * bf_lo(gw4[q]);
                        const float m1 = bf_hi(sw[q]) * (w0[j1] * pm2[j1] + w1[j1] * pm1[j1] + w2[j1] * pc1) + h1 * bf_hi(gw4[q]);
                        ow[q] = cvt_pk_bf16(m0, m1);
                        pm2[j0] = pm1[j0]; pm1[j0] = pc0; pm2[j1] = pm1[j1]; pm1[j1] = pc1;
                    }
                    *(u32x4*)((char*)MERGED + ((unsigned)(t0 + tb + t) * D + c8) * 2u) = (u32x4){ow[0], ow[1], ow[2], ow[3]};
                }
            }
        }
    }
    if (!SCAN_FUSED) GRID_BAR();
    for (int rep = 0; rep < REP8; ++rep)
    { pg8::Gemm g{SCAN_FUSED ? WSP(bf16_t, WS_H) : WSP(bf16_t, WS_RX), WSP(bf16_t, WS_WOUT), M, D, D, D, D, -1}; pg8::StaticOrder S; S.init(M, D, G, cid);
      EpiResNorm<0, P10_I8 != 0> E{KARG(0), WSP(bf16_t, WS_BX), WSP(float, WS_MOD) + 2048, WSP(float, WS_RSS1), WSP(unsigned, WS_CNT1), KARG(15), WSP(float, WS_MOD), SCAN_FUSED ? (bf16_t*)OUTP : WSP(bf16_t, WS_H), WSP(unsigned, WS_RMX), WSP(float, WS_SA2), WSP(float, WS_SHMAX)}; pg8::gemm_phase(lds, g, S, E); }
    GRID_BAR();
    for (int rep = 0; rep < REP10; ++rep)
    if (P10_I8) { pg8::GemmI8 g{SCAN_FUSED ? (const signed char*)OUTP : WSP(signed char, WS_H), WSP(signed char, WS_WGU), M, NGU, D, D, D}; pg8::StaticOrder S; S.init(M, NGU, G, cid);
      EpiI8<EpiGU> E{WSP(float, WS_SA2), WSP(float, WS_SBGU), EpiGU{WSP(bf16_t, WS_ACT)}, 0}; pg8::gemm_phase_i8(lds, g, S, E); }
    else { pg8::Gemm g{WSP(bf16_t, WS_H), WSP(bf16_t, WS_WGU), M, NGU, D, D, D, -1}; pg8::StaticOrder S; S.init(M, NGU, G, cid); EpiGU E{WSP(bf16_t, WS_ACT)}; pg8::gemm_phase(lds, g, S, E); }
    GRID_BAR();
    for (int rep = 0; rep < REP11; ++rep)
    { pg8::Gemm g{WSP(bf16_t, WS_ACT), WSP(bf16_t, WS_WDN), M, D, FF, FF, FF, -1}; pg8::StaticOrder S; S.init(M, D, G, cid);
      EpiResNorm<1> E{WSP(bf16_t, WS_BX), OUTP, WSP(float, WS_MOD) + 5120, WSP(float, WS_RSS2), WSP(unsigned, WS_CNT2), KARG(18), nullptr, nullptr, nullptr, nullptr, nullptr}; pg8::gemm_phase(lds, g, S, E); }
    if (pass + 1 < NPASS) GRID_BAR();
    }
}

extern "C" void kernel_launch(void* const* d_in, const int* in_sizes, int n_in, void* d_out, int out_size, void* d_ws, size_t ws_size, hipStream_t stream) {
    static int grid_blocks = 0;
    if (grid_blocks == 0) {
        if (n_in != 19 || out_size != M * D || ws_size < WS_END) { fprintf(stderr, "kernel_launch: unexpected shapes (n_in %d out %d ws %zu)\n", n_in, out_size, ws_size); grid_blocks = -1; return; }
        int dev = 0, cus = 0, per_cu = 0;
        hipGetDevice(&dev);
        hipDeviceGetAttribute(&cus, hipDeviceAttributeMultiprocessorCount, dev);
        hipFuncSetAttribute((const void*)fwd_megakernel, hipFuncAttributeMaxDynamicSharedMemorySize, LDS_BYTES);
        hipOccupancyMaxActiveBlocksPerMultiprocessor(&per_cu, (const void*)fwd_megakernel, 512, LDS_BYTES);
        if (per_cu < 1) { fprintf(stderr, "kernel_launch: occupancy query says %d blocks per CU\n", per_cu); grid_blocks = -1; return; }
        if (SCAN_FUSED && cus != 256) { fprintf(stderr, "kernel_launch: the chain-ordered scan phase is laid out for 256 CUs, this device has %d\n", cus); grid_blocks = -1; return; }
        grid_blocks = cus;
    }
    if (grid_blocks < 0) return;
    if (hipMemsetAsync((char*)d_ws + WS_BAR, 0, (WS_CTL_END - WS_BAR), stream) != hipSuccess) { fprintf(stderr, "kernel_launch: memset of the barrier words failed\n"); return; }
    Params p{};
    for (int i = 0; i < 19; ++i) p.in[i] = (const float*)d_in[i];
    p.out = (float*)d_out; p.ws = (unsigned char*)d_ws;
    void* args[] = {&p};
    hipError_t e = hipLaunchCooperativeKernel((const void*)fwd_megakernel, dim3(grid_blocks), dim3(512), args, LDS_BYTES, stream);
    if (e != hipSuccess) fprintf(stderr, "cooperative launch failed: %s (grid %d)\n", hipGetErrorString(e), grid_blocks);
}
```

```cpp
#include <hip/hip_runtime.h>
#include <hip/hip_cooperative_groups.h>
#include <cstdio>
namespace cg = cooperative_groups;

#define LAS __attribute__((address_space(3)))
typedef unsigned short bf16_t;
typedef short bf16x8 __attribute__((ext_vector_type(8)));
typedef float f32x4 __attribute__((ext_vector_type(4)));
typedef float f32x2 __attribute__((ext_vector_type(2)));
typedef unsigned u32x4 __attribute__((ext_vector_type(4)));
typedef unsigned u32x2 __attribute__((ext_vector_type(2)));
typedef int i32x4 __attribute__((ext_vector_type(4)));

constexpr int M = 32768, D = 1024, SEQ = 8192, FF = 2816, NIN = 7168, NGU = 5632, NMOD = 6144;
constexpr float EPS = 1e-6f;
constexpr size_t MiB = (size_t)1 << 20;
constexpr size_t WS_MOD = 0, WS_LS8 = 128 * 1024, WS_APROD = 1 * MiB, WS_HEND = 3 * MiB, WS_CIN = 5 * MiB;
constexpr size_t WS_WIN = 8 * MiB, WS_WGU = 22 * MiB, WS_WDN = 33 * MiB, WS_WOUT = 39 * MiB, WS_WRG = 41 * MiB;
constexpr size_t WS_H = 48 * MiB, WS_SA = 112 * MiB, WS_P = 176 * MiB, WS_G2 = 240 * MiB, WS_RX = 304 * MiB, WS_BX = 368 * MiB, WS_END = 496 * MiB;
constexpr size_t WS_ACT = 112 * MiB;
constexpr int LDS_XCH = 131072 + 16;
constexpr int LDS_BYTES = 131072 + 16 + 1024;
constexpr size_t WS_BAR = 256 * 1024;
constexpr size_t WS_RSS1 = 272 * 1024, WS_RSS2 = 400 * 1024;
constexpr size_t WS_CNT1 = 528 * 1024, WS_CNT2 = 592 * 1024;
constexpr size_t WS_CMAXIN = 656 * 1024, WS_CMAXGU = 688 * 1024;
constexpr size_t WS_RMX = 720 * 1024, WS_FLAG = 848 * 1024, WS_CTL_END = 852 * 1024;
constexpr size_t WS_TOT = 1 * MiB;
constexpr size_t WS_SA1 = 5 * MiB, WS_SA2 = WS_SA1 + 128 * 1024, WS_SBIN = WS_SA2 + 128 * 1024, WS_SBGU = WS_SBIN + 32 * 1024, WS_SHMAX = WS_SBGU + 32 * 1024;
#ifndef P2_I8
#define P2_I8 2
#endif
#ifndef P10_I8
#define P10_I8 1
#endif
#ifndef FIX_IN_P4
#define FIX_IN_P4 1
#endif
#ifndef SCAN_FUSED
#define SCAN_FUSED 1
#endif
#ifndef CONV4_FUSED
#define CONV4_FUSED 1
#endif
#ifndef CONV3_FUSED
#define CONV3_FUSED 1
#endif
#ifndef KREP2
#define KREP2 1
#endif
#ifndef EREPX
#define EREPX 1
#endif
#ifndef NPASS
#define NPASS 1
#endif
#ifndef REP1
#define REP1 1
#endif
#ifndef REP3
#define REP3 1
#endif
#ifndef REP7
#define REP7 1
#endif
#ifndef REP0
#define REP0 1
#endif
#ifndef REP2
#define REP2 1
#endif
#ifndef REP4
#define REP4 1
#endif
#ifndef REP8
#define REP8 1
#endif
#ifndef REP10
#define REP10 1
#endif
#ifndef REP11
#define REP11 1
#endif

namespace pg8 {
constexpr int BM = 256, BK = 64, HALF = 128, HTB = HALF * BK * 2, STAGE_BYTES = 8 * HTB, NXCD = 8, WGM = 4;
__host__ __device__ __forceinline__ int lds_byte(int r, int c) { const int st = (r >> 4) * 2 + (c >> 5), rr = r & 15, cc = c & 31, ob = rr * 64 + cc * 2; return st * 1024 + (ob ^ (((ob >> 9) & 1) << 5)); }
__host__ __device__ __forceinline__ void stage_rc(int b, int& R, int& C) { const int st = b / 1024, sb = b % 1024, swz = sb ^ (((sb >> 9) & 1) << 5); R = (st >> 1) * 16 + swz / 64; C = (st & 1) * 32 + (swz % 64) / 2; }
struct Unit { int pm, pn; };
struct Gemm { const bf16_t* A; const bf16_t* Bt; int M, N, K, lda, ldb, a_pn_shift; };
struct StaticOrder {
    int nM, nN, nwg, G, c, chain;
    __host__ __device__ void init(int M_, int N_, int G_, int c_) { nM = M_ / BM; nN = N_ / BM; nwg = nM * nN; G = G_; c = c_; chain = 0; }
    __host__ __device__ bool next(int i, Unit& u) const {
        if (chain) { if (i >= 4) return false; const int x = c & 7, j = c >> 3; u.pm = 32 * (x >> 1) + 8 * i + (x & 1) * 4 + (j >> 3); u.pn = j & 7; return true; }
        const long L = (long)i * G + c; if (L >= nwg) return false;
        int wgid = (int)L; { const int q = nwg / NXCD, r = nwg % NXCD, xcd = wgid % NXCD, off = wgid / NXCD; wgid = (xcd < r ? xcd * (q + 1) : r * (q + 1) + (xcd - r) * q) + off; }
        const int nig = WGM * nN, gid = wgid / nig, fm = gid * WGM, gsz = (nM - fm) < WGM ? (nM - fm) : WGM;
        u.pm = fm + ((wgid % nig) % gsz); u.pn = (wgid % nig) / gsz; return true;
    }
};
__device__ __forceinline__ unsigned cvt_pk_bf16(float lo, float hi) { unsigned r; asm volatile("v_cvt_pk_bf16_f32 %0, %1, %2" : "=v"(r) : "v"(lo), "v"(hi)); return r; }

template <class Epi, bool APERM = false, int KREP = 1, int EREP = 1>
__device__ __forceinline__ void gemm_phase(LAS unsigned char* lds, const Gemm g, const StaticOrder& S, const Epi& E) {
    int tid = threadIdx.x; asm volatile("" : "+v"(tid));
    const int wid = __builtin_amdgcn_readfirstlane(tid >> 6), lane = tid & 63, wr = wid >> 2, wc = wid & 3, fr = lane & 15, fq = lane >> 4;
    int K = g.K; asm volatile("" : "+s"(K)); const int nt = K / BK;
    unsigned voffA[2], voffB[2];
#pragma unroll
    for (int i = 0; i < 2; ++i) { int R, C; stage_rc(tid * 16 + i * 8192, R, C); const int Ra = APERM ? (8 * ((R & 15) + 16 * (R >> 6)) + ((R >> 4) & 3)) : R; voffA[i] = (unsigned)(Ra * g.lda + C) * 2u; voffB[i] = (unsigned)(R * g.ldb + C) * 2u; }
    const size_t kstep = (size_t)(BK * 2);
    const size_t hstepA = (size_t)(APERM ? 4 : HALF) * g.lda * 2, hstepB = (size_t)HALF * g.ldb * 2;
    const size_t tstepA = (size_t)BM * g.lda * 2, tstepB = 2 * hstepB;
    const unsigned ldsw = (unsigned)wid * 1024u;
    const int aoff = lds_byte(wr * 64 + fr, fq * 8), boff = lds_byte(wc * 32 + fr, fq * 8);
#define PG8_SA(b, h) (((b) * 2 + (h)) * HTB)
#define PG8_SB(b, h) ((4 + (b) * 2 + (h)) * HTB)
#define PG8_STAGE(bufoff, gbase, voff) do { _Pragma("unroll") for (int _i = 0; _i < 2; ++_i) \
        __builtin_amdgcn_global_load_lds((const unsigned*)((const char*)(gbase) + (voff)[_i]), (LAS unsigned*)(lds + (bufoff) + ldsw + _i * 8192), 16, 0, 0); } while (0)
#define PG8_LDA(dst, b, h) do { _Pragma("unroll") for (int m = 0; m < 4; ++m) _Pragma("unroll") for (int k = 0; k < 2; ++k) dst[m][k] = *(const LAS bf16x8*)(lds + PG8_SA(b, h) + aoff + m * 2048 + k * 1024); } while (0)
#define PG8_LDB(dst, b, h) do { _Pragma("unroll") for (int n = 0; n < 2; ++n) _Pragma("unroll") for (int k = 0; k < 2; ++k) dst[n][k] = *(const LAS bf16x8*)(lds + PG8_SB(b, h) + boff + n * 2048 + k * 1024); } while (0)
#define PG8_MMA(ai, bj, At, Bt) do { __builtin_amdgcn_s_setprio(1); _Pragma("unroll") for (int m = 0; m < 4; ++m) _Pragma("unroll") for (int n = 0; n < 2; ++n) _Pragma("unroll") for (int k = 0; k < 2; ++k) \
        acc[ai][bj][m][n] = __builtin_amdgcn_mfma_f32_16x16x32_bf16(Bt[n][k], At[m][k], acc[ai][bj][m][n], 0, 0, 0); __builtin_amdgcn_s_setprio(0); } while (0)
#define PG8_WAIT_V(n) asm volatile("s_waitcnt vmcnt(" #n ")" ::: "memory")
#define PG8_WAIT_L(n) asm volatile("s_waitcnt lgkmcnt(" #n ")" ::: "memory")
#define PG8_BAR __builtin_amdgcn_s_barrier()
#define PG8_SCHED __builtin_amdgcn_sched_barrier(0)
#define PG8_APTR(u) ((const char*)g.A + (size_t)(u).pm * tstepA + (g.a_pn_shift >= 0 ? (size_t)((u).pn >> g.a_pn_shift) * (size_t)K * 2 : (size_t)0))
#define PG8_BPTR(u) ((const char*)g.Bt + (size_t)(u).pn * tstepB)
    Unit cur, nxt; int ui = 0;
    if (!S.next(0, cur)) return;
    f32x4 acc[2][2][4][2];
#pragma unroll
    for (int a = 0; a < 2; ++a)
#pragma unroll
        for (int b = 0; b < 2; ++b)
#pragma unroll
            for (int m = 0; m < 4; ++m)
#pragma unroll
                for (int n = 0; n < 2; ++n) acc[a][b][m][n] = (f32x4){0.f, 0.f, 0.f, 0.f};
    bf16x8 At[4][2], B0[2][2], B1[2][2];
    const char* cA = PG8_APTR(cur); const char* cB = PG8_BPTR(cur);
    PG8_STAGE(PG8_SB(0, 0), cB, voffB); PG8_STAGE(PG8_SA(0, 0), cA, voffA); PG8_STAGE(PG8_SB(0, 1), cB + hstepB, voffB); PG8_STAGE(PG8_SA(0, 1), cA + hstepA, voffA);
    if (wr == 1) PG8_BAR;
    PG8_WAIT_V(4); PG8_BAR;
    PG8_STAGE(PG8_SB(1, 0), cB + kstep, voffB); PG8_STAGE(PG8_SA(1, 0), cA + kstep, voffA); PG8_STAGE(PG8_SB(1, 1), cB + hstepB + kstep, voffB);
    PG8_WAIT_V(6); PG8_BAR;
    for (;;) {
        const bool has_next = S.next((ui + 1) / KREP, nxt);
        const char* nA = has_next ? PG8_APTR(nxt) : cA; const char* nB = has_next ? PG8_BPTR(nxt) : cB;
#pragma unroll 1
        for (int t = 0; t < nt; t += 2) {
            const bool last = (t == nt - 2);
            const char* a1 = cA + (size_t)(t + 1) * kstep;
            const char* a2 = last ? nA : cA + (size_t)(t + 2) * kstep; const char* b2 = last ? nB : cB + (size_t)(t + 2) * kstep;
            const char* a3 = a2 + kstep; const char* b3 = b2 + kstep;
            PG8_LDB(B0, 0, 0); PG8_SCHED; PG8_LDA(At, 0, 0); PG8_STAGE(PG8_SA(1, 1), a1 + hstepA, voffA);
            PG8_WAIT_L(8); PG8_BAR; PG8_WAIT_L(0); PG8_MMA(0, 0, At, B0); PG8_BAR; PG8_SCHED;
            PG8_LDB(B1, 0, 1); PG8_STAGE(PG8_SB(0, 0), b2, voffB);
            PG8_BAR; PG8_WAIT_L(0); PG8_MMA(0, 1, At, B1); PG8_BAR;
            PG8_LDA(At, 0, 1); PG8_STAGE(PG8_SA(0, 0), a2, voffA);
            PG8_BAR; PG8_WAIT_L(0); PG8_MMA(1, 0, At, B0); PG8_BAR; PG8_SCHED;
            PG8_STAGE(PG8_SB(0, 1), b2 + hstepB, voffB);
            PG8_WAIT_V(6); PG8_BAR; PG8_MMA(1, 1, At, B1); PG8_BAR;
            PG8_LDB(B0, 1, 0); PG8_SCHED; PG8_LDA(At, 1, 0); PG8_STAGE(PG8_SA(0, 1), a2 + hstepA, voffA);
            PG8_WAIT_L(8); PG8_BAR; PG8_WAIT_L(0); PG8_MMA(0, 0, At, B0); PG8_BAR; PG8_SCHED;
            PG8_LDB(B1, 1, 1); PG8_STAGE(PG8_SB(1, 0), b3, voffB);
            PG8_BAR; PG8_WAIT_L(0); PG8_MMA(0, 1, At, B1); PG8_BAR;
            PG8_LDA(At, 1, 1); PG8_STAGE(PG8_SA(1, 0), a3, voffA);
            PG8_BAR; PG8_WAIT_L(0); PG8_MMA(1, 0, At, B0); PG8_BAR; PG8_SCHED;
            PG8_STAGE(PG8_SB(1, 1), b3 + hstepB, voffB);
            PG8_WAIT_V(6); PG8_BAR; PG8_MMA(1, 1, At, B1); PG8_BAR;
        }
        if ((ui % KREP) == KREP - 1) {
        if (wr == 0) PG8_BAR;
        E(acc, cur, wr, wc, fr, fq);
        if (EREP > 1) {
_Pragma("unroll") for (int a = 0; a < 2; ++a) _Pragma("unroll") for (int b = 0; b < 2; ++b) _Pragma("unroll") for (int m = 0; m < 4; ++m) _Pragma("unroll") for (int n = 0; n < 2; ++n) asm volatile("" : "+v"(acc[a][b][m][n]));
            E(acc, cur, wr, wc, fr, fq); }
        if (wr == 1) PG8_BAR;
        }
        if (!has_next) break;
#pragma unroll
        for (int a = 0; a < 2; ++a)
#pragma unroll
            for (int b = 0; b < 2; ++b)
#pragma unroll
                for (int m = 0; m < 4; ++m)
#pragma unroll
                    for (int n = 0; n < 2; ++n) acc[a][b][m][n] = (f32x4){0.f, 0.f, 0.f, 0.f};
        cur = nxt; cA = nA; cB = nB; ++ui;
    }
    PG8_WAIT_V(0);
    if (wr == 0) PG8_BAR;
    PG8_BAR;
#undef PG8_SA
#undef PG8_SB
#undef PG8_STAGE
#undef PG8_LDA
#undef PG8_LDB
#undef PG8_MMA
#undef PG8_WAIT_V
#undef PG8_WAIT_L
#undef PG8_BAR
#undef PG8_SCHED
#undef PG8_APTR
#undef PG8_BPTR
}

struct GemmI8 { const signed char* A; const signed char* Bt; int M, N, K, lda, ldb; };
template <class Epi, bool APERM = false>
__device__ __forceinline__ void gemm_phase_i8(LAS unsigned char* lds, const GemmI8 g, const StaticOrder& S, const Epi& E) {
    int tid = threadIdx.x; asm volatile("" : "+v"(tid));
    const int wid = __builtin_amdgcn_readfirstlane(tid >> 6), lane = tid & 63, wr = wid >> 2, wc = wid & 3, fr = lane & 15, fq = lane >> 4;
    int K = g.K; asm volatile("" : "+s"(K)); const int nt = K / 128;
    unsigned voffA[2], voffB[2];
#pragma unroll
    for (int i = 0; i < 2; ++i) { int R, C; stage_rc(tid * 16 + i * 8192, R, C); const int Ra = APERM ? (8 * ((R & 15) + 16 * (R >> 6)) + ((R >> 4) & 3)) : R; voffA[i] = (unsigned)(Ra * g.lda + 2 * C); voffB[i] = (unsigned)(R * g.ldb + 2 * C); }
    const size_t kstep = (size_t)(BK * 2);
    const size_t hstepA = (size_t)(APERM ? 4 : HALF) * g.lda, hstepB = (size_t)HALF * g.ldb;
    const size_t tstepA = (size_t)BM * g.lda, tstepB = 2 * hstepB;
    const unsigned ldsw = (unsigned)wid * 1024u;
    const int aoff = lds_byte(wr * 64 + fr, fq * 8), boff = lds_byte(wc * 32 + fr, fq * 8);
#define PG8_SA(b, h) (((b) * 2 + (h)) * HTB)
#define PG8_SB(b, h) ((4 + (b) * 2 + (h)) * HTB)
#define PG8_STAGE(bufoff, gbase, voff) do { _Pragma("unroll") for (int _i = 0; _i < 2; ++_i) \
        __builtin_amdgcn_global_load_lds((const unsigned*)((const char*)(gbase) + (voff)[_i]), (LAS unsigned*)(lds + (bufoff) + ldsw + _i * 8192), 16, 0, 0); } while (0)
#define PG8_LDA(dst, b, h) do { _Pragma("unroll") for (int m = 0; m < 4; ++m) _Pragma("unroll") for (int k = 0; k < 2; ++k) dst[m][k] = *(const LAS bf16x8*)(lds + PG8_SA(b, h) + aoff + m * 2048 + k * 1024); } while (0)
#define PG8_LDB(dst, b, h) do { _Pragma("unroll") for (int n = 0; n < 2; ++n) _Pragma("unroll") for (int k = 0; k < 2; ++k) dst[n][k] = *(const LAS bf16x8*)(lds + PG8_SB(b, h) + boff + n * 2048 + k * 1024); } while (0)
#define PG8_MMA(ai, bj, At, Bt) do { __builtin_amdgcn_s_setprio(1); _Pragma("unroll") for (int m = 0; m < 4; ++m) _Pragma("unroll") for (int n = 0; n < 2; ++n) _Pragma("unroll") for (int k = 0; k < 2; ++k) \
        acc[ai][bj][m][n] = __builtin_amdgcn_mfma_i32_16x16x64_i8(__builtin_bit_cast(i32x4, Bt[n][k]), __builtin_bit_cast(i32x4, At[m][k]), acc[ai][bj][m][n], 0, 0, 0); __builtin_amdgcn_s_setprio(0); } while (0)
#define PG8_WAIT_V(n) asm volatile("s_waitcnt vmcnt(" #n ")" ::: "memory")
#define PG8_WAIT_L(n) asm volatile("s_waitcnt lgkmcnt(" #n ")" ::: "memory")
#define PG8_BAR __builtin_amdgcn_s_barrier()
#define PG8_SCHED __builtin_amdgcn_sched_barrier(0)
#define PG8_APTR(u) ((const char*)g.A + (size_t)(u).pm * tstepA)
#define PG8_BPTR(u) ((const char*)g.Bt + (size_t)(u).pn * tstepB)
    Unit cur, nxt; int ui = 0;
    if (!S.next(0, cur)) return;
    i32x4 acc[2][2][4][2];
#pragma unroll
    for (int a = 0; a < 2; ++a)
#pragma unroll
        for (int b = 0; b < 2; ++b)
#pragma unroll
            for (int m = 0; m < 4; ++m)
#pragma unroll
                for (int n = 0; n < 2; ++n) acc[a][b][m][n] = (i32x4){0, 0, 0, 0};
    bf16x8 At[4][2], B0[2][2], B1[2][2];
    const char* cA = PG8_APTR(cur); const char* cB = PG8_BPTR(cur);
    PG8_STAGE(PG8_SB(0, 0), cB, voffB); PG8_STAGE(PG8_SA(0, 0), cA, voffA); PG8_STAGE(PG8_SB(0, 1), cB + hstepB, voffB); PG8_STAGE(PG8_SA(0, 1), cA + hstepA, voffA);
    if (wr == 1) PG8_BAR;
    PG8_WAIT_V(4); PG8_BAR;
    PG8_STAGE(PG8_SB(1, 0), cB + kstep, voffB); PG8_STAGE(PG8_SA(1, 0), cA + kstep, voffA); PG8_STAGE(PG8_SB(1, 1), cB + hstepB + kstep, voffB);
    PG8_WAIT_V(6); PG8_BAR;
    for (;;) {
        const bool has_next = S.next(ui + 1, nxt);
        const char* nA = has_next ? PG8_APTR(nxt) : cA; const char* nB = has_next ? PG8_BPTR(nxt) : cB;
#pragma unroll 1
        for (int t = 0; t < nt; t += 2) {
            const bool last = (t == nt - 2);
            const char* a1 = cA + (size_t)(t + 1) * kstep;
            const char* a2 = last ? nA : cA + (size_t)(t + 2) * kstep; const char* b2 = last ? nB : cB + (size_t)(t + 2) * kstep;
            const char* a3 = a2 + kstep; const char* b3 = b2 + kstep;
            PG8_LDB(B0, 0, 0); PG8_SCHED; PG8_LDA(At, 0, 0); PG8_STAGE(PG8_SA(1, 1), a1 + hstepA, voffA);
            PG8_WAIT_L(8); PG8_BAR; PG8_WAIT_L(0); PG8_MMA(0, 0, At, B0); PG8_BAR; PG8_SCHED;
            PG8_LDB(B1, 0, 1); PG8_STAGE(PG8_SB(0, 0), b2, voffB);
            PG8_BAR; PG8_WAIT_L(0); PG8_MMA(0, 1, At, B1); PG8_BAR;
            PG8_LDA(At, 0, 1); PG8_STAGE(PG8_SA(0, 0), a2, voffA);
            PG8_BAR; PG8_WAIT_L(0); PG8_MMA(1, 0, At, B0); PG8_BAR; PG8_SCHED;
            PG8_STAGE(PG8_SB(0, 1), b2 + hstepB, voffB);
            PG8_WAIT_V(6); PG8_BAR; PG8_MMA(1, 1, At, B1); PG8_BAR;
            PG8_LDB(B0, 1, 0); PG8_SCHED; PG8_LDA(At, 1, 0); PG8_STAGE(PG8_SA(0, 1), a2 + hstepA, voffA);
            PG8_WAIT_L(8); PG8_BAR; PG8_WAIT_L(0); PG8_MMA(0, 0, At, B0); PG8_BAR; PG8_SCHED;
            PG8_LDB(B1, 1, 1); PG8_STAGE(PG8_SB(1, 0), b3, voffB);
            PG8_BAR; PG8_WAIT_L(0); PG8_MMA(0, 1, At, B1); PG8_BAR;
            PG8_LDA(At, 1, 1); PG8_STAGE(PG8_SA(1, 0), a3, voffA);
            PG8_BAR; PG8_WAIT_L(0); PG8_MMA(1, 0, At, B0); PG8_BAR; PG8_SCHED;
            PG8_STAGE(PG8_SB(1, 1), b3 + hstepB, voffB);
            PG8_WAIT_V(6); PG8_BAR; PG8_MMA(1, 1, At, B1); PG8_BAR;
        }
        if (wr == 0) PG8_BAR;
        E(acc, cur, wr, wc, fr, fq);
        if (wr == 1) PG8_BAR;
        if (!has_next) break;
#pragma unroll
        for (int a = 0; a < 2; ++a)
#pragma unroll
            for (int b = 0; b < 2; ++b)
#pragma unroll
                for (int m = 0; m < 4; ++m)
#pragma unroll
                    for (int n = 0; n < 2; ++n) acc[a][b][m][n] = (i32x4){0, 0, 0, 0};
        cur = nxt; cA = nA; cB = nB; ++ui;
    }
    PG8_WAIT_V(0);
    if (wr == 0) PG8_BAR;
    PG8_BAR;
#undef PG8_SA
#undef PG8_SB
#undef PG8_STAGE
#undef PG8_LDA
#undef PG8_LDB
#undef PG8_MMA
#undef PG8_WAIT_V
#undef PG8_WAIT_L
#undef PG8_BAR
#undef PG8_SCHED
#undef PG8_APTR
#undef PG8_BPTR
}
}
using pg8::cvt_pk_bf16;


#define XB_TMO      128
#define XB_XCNT(j)  (256  + 64 * (j))
#define XB_XSUB(j)  (1280 + 64 * (j))
#define XB_XGEN(j)  (2304 + 64 * (j))
#define XB_TOP      3328
#define XB_TOPGEN   3392
#define XCD_BAR_WORDS 3456
#define XB_SPIN_CAP (1u << 18)
__device__ __forceinline__ unsigned xb_ld(unsigned* p)              { return __hip_atomic_load(p, __ATOMIC_RELAXED, __HIP_MEMORY_SCOPE_AGENT); }
__device__ __forceinline__ unsigned xb_add(unsigned* p, unsigned v) { return __hip_atomic_fetch_add(p, v, __ATOMIC_RELAXED, __HIP_MEMORY_SCOPE_AGENT); }
__device__ __forceinline__ unsigned xb_xcc_id() { return (unsigned)__builtin_amdgcn_s_getreg((3 << 11) | 20) & 0xFu; }
#define XB_SPIN(cond, bar) do { unsigned _sp = 0; while (cond) { __builtin_amdgcn_s_sleep(1); \
    if ((++_sp & 255u) == 0u) { if (xb_ld(&(bar)[XB_TMO])) break; if (_sp > XB_SPIN_CAP) { atomicAdd(&(bar)[XB_TMO], 1u); break; } } } } while (0)
struct XcdBarrier { unsigned* bar; unsigned x; volatile LAS unsigned* st; };
__device__ __forceinline__ void xcd_barrier_post(unsigned* bar) { if (threadIdx.x == 0) (void)xb_add(&bar[XB_XCNT(xb_xcc_id())], 1u); }
__device__ __forceinline__ void xcd_barrier_complete(unsigned* bar, unsigned x, unsigned& nloc, unsigned& nx) {
    const unsigned G = gridDim.x * gridDim.y * gridDim.z;
    unsigned sum, cnt, mine, sp = 0u;
    for (;;) {
        sum = 0u; cnt = 0u; mine = 0u;
#pragma unroll
        for (unsigned j = 0; j < 16; ++j) { const unsigned c = xb_ld(&bar[XB_XCNT(j)]); sum += c; cnt += (c > 0u) ? 1u : 0u; mine = (j == x) ? c : mine; }
        if (sum == G) break;
        __builtin_amdgcn_s_sleep(1);
        if ((++sp & 255u) == 0u) { if (xb_ld(&bar[XB_TMO])) break; if (sp > XB_SPIN_CAP) { atomicAdd(&bar[XB_TMO], 1u); break; } }
    }
    nloc = mine > 0u ? mine : 1u; nx = cnt > 0u ? cnt : 1u;
}
__device__ __forceinline__ void xcd_barrier(const XcdBarrier& b) {
    asm volatile("s_waitcnt vmcnt(0)" ::: "memory");
    __syncthreads();
    if (threadIdx.x == 0) {
        unsigned* bar = b.bar;
        __builtin_amdgcn_s_waitcnt(0);
        unsigned nloc = b.st[0], nx = b.st[1];
        if (nloc == 0u) { xcd_barrier_complete(bar, b.x, nloc, nx); b.st[0] = nloc; b.st[1] = nx; }
        const unsigned old = xb_add(&bar[XB_XSUB(b.x)], 1u);
        const unsigned gen = old / nloc;
        if (old + 1u == (gen + 1u) * nloc) {
            __builtin_amdgcn_fence(__ATOMIC_RELEASE, "agent");
            asm volatile("s_waitcnt vmcnt(0)" ::: "memory");
            const unsigned og = xb_add(&bar[XB_TOP], 1u);
            const unsigned tg = og / nx;
            if (og + 1u == (tg + 1u) * nx) xb_add(&bar[XB_TOPGEN], 1u);
            else XB_SPIN(xb_ld(&bar[XB_TOPGEN]) == tg, bar);
            __builtin_amdgcn_fence(__ATOMIC_ACQUIRE, "agent");
            xb_add(&bar[XB_XGEN(b.x)], 1u);
            asm volatile("s_waitcnt vmcnt(0)" ::: "memory");
        } else {
            XB_SPIN(xb_ld(&bar[XB_XGEN(b.x)]) == gen, bar);
            __builtin_amdgcn_fence(__ATOMIC_ACQUIRE, "agent");
            asm volatile("s_waitcnt vmcnt(0)" ::: "memory");
        }
    }
    __syncthreads();
}

__device__ __forceinline__ float sigm(float x) { return __builtin_amdgcn_rcpf(1.0f + __expf(-x)); }
__device__ __forceinline__ float gelu_tanh(float x) { return x * sigm(1.5957691216057308f * (x + 0.044715f * x * x * x)); }
__device__ __forceinline__ float sigm_gelu(float gb, float x) {
    const float t = x * x, u = __builtin_fmaf(t, -1.5957691216057308f * 1.4426950408889634f * 0.044715f, -1.5957691216057308f * 1.4426950408889634f);
    const float e1 = __builtin_amdgcn_exp2f(x * u), e2 = __builtin_amdgcn_exp2f(gb * -1.4426950408889634f);
    const float d = __builtin_fmaf(e1, e2, e1 + e2) + 1.0f;
    return x * __builtin_amdgcn_rcpf(d);
}
__device__ __forceinline__ float bf_lo(unsigned u) { return __uint_as_float(u << 16); }
__device__ __forceinline__ float bf_hi(unsigned u) { return __uint_as_float(u & 0xffff0000u); }
__device__ __forceinline__ float wave_sum(float v) {
#pragma unroll
    for (int o = 32; o >= 1; o >>= 1) v += __shfl_xor(v, o);
    return v;
}
__device__ __forceinline__ int slot8(int cit) { return (cit & ~31) | (((cit >> 2) & 1) << 4) | (((cit >> 3) & 3) << 2) | (cit & 3); }

struct Epi1 {
    bf16_t *sA, *p, *g2, *rx;
    __device__ __forceinline__ void operator()(const f32x4 (&acc)[2][2][4][2], const pg8::Unit& u, int wr, int wc, int fr, int fq) const {
        const int row0 = u.pm * 256 + wr * 64 + fr;
        if (u.pn < 16) {
            const int ch = u.pn * 64 + wc * 16 + fq * 4;
#pragma unroll
            for (int ai = 0; ai < 2; ++ai)
#pragma unroll
                for (int m = 0; m < 4; ++m) {
                    const size_t off = (size_t)(row0 + ai * 128 + m * 16) * D + ch;
                    const f32x4 cb = acc[ai][0][m][0], cc = acc[ai][0][m][1], cx = acc[ai][1][m][0], ga = acc[ai][1][m][1];
                    float s[4], q[4];
#pragma unroll
                    for (int j = 0; j < 4; ++j) { s[j] = sigm(ga[j]) * cb[j]; q[j] = cc[j] * cx[j]; }
                    u32x2 w0, w1; w0.x = cvt_pk_bf16(s[0], s[1]); w0.y = cvt_pk_bf16(s[2], s[3]); w1.x = cvt_pk_bf16(q[0], q[1]); w1.y = cvt_pk_bf16(q[2], q[3]);
                    *(u32x2*)(sA + off) = w0; *(u32x2*)(p + off) = w1;
                }
        } else if (u.pn < 24) {
            const int ch = (u.pn - 16) * 128 + wc * 32 + fq * 8;
#pragma unroll
            for (int ai = 0; ai < 2; ++ai)
#pragma unroll
                for (int m = 0; m < 4; ++m) {
                    const size_t off = (size_t)(row0 + ai * 128 + m * 16) * D + ch;
                    float v[8];
#pragma unroll
                    for (int n = 0; n < 2; ++n)
#pragma unroll
                        for (int j = 0; j < 4; ++j) v[4 * n + j] = sigm_gelu(acc[ai][1][m][n][j], acc[ai][0][m][n][j]);
                    u32x4 w; w.x = cvt_pk_bf16(v[0], v[1]); w.y = cvt_pk_bf16(v[2], v[3]); w.z = cvt_pk_bf16(v[4], v[5]); w.w = cvt_pk_bf16(v[6], v[7]);
                    *(u32x4*)(g2 + off) = w;
                }
        } else {
#pragma unroll
            for (int ai = 0; ai < 2; ++ai)
#pragma unroll
                for (int m = 0; m < 4; ++m)
#pragma unroll
                    for (int bj = 0; bj < 2; ++bj) {
                        const size_t off = (size_t)(row0 + ai * 128 + m * 16) * D + (u.pn - 24) * 256 + bj * 128 + wc * 32 + fq * 8;
                        const f32x4 v0 = acc[ai][bj][m][0], v1 = acc[ai][bj][m][1];
                        u32x4 w; w.x = cvt_pk_bf16(v0[0], v0[1]); w.y = cvt_pk_bf16(v0[2], v0[3]); w.z = cvt_pk_bf16(v1[0], v1[1]); w.w = cvt_pk_bf16(v1[2], v1[3]);
                        *(u32x4*)(rx + off) = w;
                    }
        }
    }
};

template <class Inner> struct EpiI8 {
    const float* sa; const float* sb; Inner inner; int pn_off;
    __device__ __forceinline__ void operator()(const i32x4 (&acc)[2][2][4][2], const pg8::Unit& u, int wr, int wc, int fr, int fq) const {
        const int row0 = u.pm * 256 + wr * 64 + fr, col0 = u.pn * 256 + wc * 32 + 4 * fq;
        f32x4 sbv[2][2]; float sav[2][4];
#pragma unroll
        for (int bj = 0; bj < 2; ++bj)
#pragma unroll
            for (int n = 0; n < 2; ++n) sbv[bj][n] = *(const f32x4*)(sb + col0 + bj * 128 + n * 16);
#pragma unroll
        for (int ai = 0; ai < 2; ++ai)
#pragma unroll
            for (int m = 0; m < 4; ++m) sav[ai][m] = sa[row0 + ai * 128 + m * 16];
        f32x4 f[2][2][4][2];
#pragma unroll
        for (int ai = 0; ai < 2; ++ai)
#pragma unroll
            for (int bj = 0; bj < 2; ++bj)
#pragma unroll
                for (int m = 0; m < 4; ++m)
#pragma unroll
                    for (int n = 0; n < 2; ++n) { const i32x4 q = acc[ai][bj][m][n]; f[ai][bj][m][n] = (f32x4){(float)q.x, (float)q.y, (float)q.z, (float)q.w} * sbv[bj][n] * sav[ai][m]; }
        const pg8::Unit ui{u.pm, u.pn + pn_off};
        inner(f, ui, wr, wc, fr, fq);
    }
};
struct EpiRG {
    const bf16_t* U; float* A; float* BX; const float* ba; const float* bx; const float* ls8;
    __device__ __forceinline__ void operator()(const f32x4 (&acc)[2][2][4][2], const pg8::Unit& u, int wr, int wc, int fr, int fq) const {
        const int row0 = u.pm * 256 + wr * 64 + fr, ch = u.pn * 128 + wc * 32 + fq * 8;
        f32x4 ba4[2], bx4[2], ls4[2];
#pragma unroll
        for (int n = 0; n < 2; ++n) { ba4[n] = *(const f32x4*)(ba + ch + 4 * n); bx4[n] = *(const f32x4*)(bx + ch + 4 * n); ls4[n] = *(const f32x4*)(ls8 + ch + 4 * n); }
#pragma unroll
        for (int ai = 0; ai < 2; ++ai)
#pragma unroll
            for (int m = 0; m < 4; ++m) {
                const int row = row0 + ai * 128 + m * 16; const bool first = (row & (SEQ - 1)) == 0;
                const size_t off = (size_t)row * D + ch;
                const u32x4 uu = *(const u32x4*)(U + off);
                const float uf[8] = {bf_lo(uu.x), bf_hi(uu.x), bf_lo(uu.y), bf_hi(uu.y), bf_lo(uu.z), bf_hi(uu.z), bf_lo(uu.w), bf_hi(uu.w)};
#pragma unroll
                for (int n = 0; n < 2; ++n) {
                    f32x4 av, bv;
#pragma unroll
                    for (int j = 0; j < 4; ++j) {
                        const float r = sigm(acc[ai][0][m][n][j] + ba4[n][j]), ig = sigm(acc[ai][1][m][n][j] + bx4[n][j]);
                        const float a = __expf(r * ls4[n][j]);
                        const float mult = first ? 1.0f : sqrtf(fmaxf(1.0f - a * a, 0.0f));
                        av[j] = a; bv[j] = mult * ig * uf[4 * n + j];
                    }
                    *(f32x4*)(A + off + 4 * n) = av; *(f32x4*)(BX + off + 4 * n) = bv;
                }
            }
    }
};

template <int N> __device__ __forceinline__ float dpp_shr(float v, float ident) {
    return __int_as_float(__builtin_amdgcn_update_dpp(__float_as_int(ident), __float_as_int(v), 0x110 | N, 0xf, 0xf, false));
}
struct EpiRG2 {
    const bf16_t* U; bf16_t* HL; bf16_t* PC; float* AT; float* HT; const float* ba; const float* bx; const float* ls8; LAS float* xch;
    __device__ __forceinline__ void operator()(f32x4 (&acc)[2][2][4][2], const pg8::Unit& u, int wr, int wc, int fr, int fq) const {
        const int ch = u.pn * 128 + wc * 32 + fq * 8, tok0 = u.pm * 256 + 8 * (fr + 16 * wr);
        float hh[8], pp[8];
        {
            f32x4 ba4[2], bx4[2], ls4[2];
#pragma unroll
            for (int n = 0; n < 2; ++n) { ba4[n] = *(const f32x4*)(ba + ch + 4 * n) * -1.4426950408889634f; bx4[n] = *(const f32x4*)(bx + ch + 4 * n) * -1.4426950408889634f; ls4[n] = *(const f32x4*)(ls8 + ch + 4 * n) * 1.4426950408889634f; }
#pragma unroll
            for (int c = 0; c < 8; ++c) { hh[c] = 0.f; pp[c] = 1.f; }
            u32x4 uq[8];
#pragma unroll
            for (int i = 0; i < 8; ++i) uq[i] = *(const u32x4*)((const char*)U + ((unsigned)(tok0 + i) * D + ch) * 2u);
#pragma unroll
            for (int ai = 0; ai < 2; ++ai)
#pragma unroll
                for (int m = 0; m < 4; ++m) {
                    __builtin_amdgcn_sched_barrier(0);
                    const int row = tok0 + 4 * ai + m; const bool first = (row & (SEQ - 1)) == 0;
                    const u32x4 uu = uq[4 * ai + m];
                    const float uf[8] = {bf_lo(uu.x), bf_hi(uu.x), bf_lo(uu.y), bf_hi(uu.y), bf_lo(uu.z), bf_hi(uu.z), bf_lo(uu.w), bf_hi(uu.w)};
#pragma unroll
                    for (int n = 0; n < 2; ++n)
#pragma unroll
                        for (int j = 0; j < 4; ++j) {
                            const int c = 4 * n + j;
                            const float r = __builtin_amdgcn_rcpf(1.0f + __builtin_amdgcn_exp2f(__builtin_fmaf(acc[ai][0][m][n][j], -1.4426950408889634f, ba4[n][j])));
                            const float ig = __builtin_amdgcn_rcpf(1.0f + __builtin_amdgcn_exp2f(__builtin_fmaf(acc[ai][1][m][n][j], -1.4426950408889634f, bx4[n][j])));
                            const float a = __builtin_amdgcn_exp2f(r * ls4[n][j]);
                            float mult = __builtin_amdgcn_sqrtf(__builtin_fmaf(-a, a, 1.0f));
                            if (ai == 0 && m == 0) mult = first ? 1.0f : mult;
                            hh[c] = a * hh[c] + mult * ig * uf[c]; pp[c] *= a;
                            acc[ai][0][m][n][j] = hh[c]; acc[ai][1][m][n][j] = pp[c];
                        }
                }
        }
        float ea[8], eh[8];
#pragma unroll
        for (int c = 0; c < 8; ++c) {
            float ia = pp[c], ih = hh[c], au, hu;
            au = dpp_shr<1>(ia, 1.f); hu = dpp_shr<1>(ih, 0.f); ih = ia * hu + ih; ia = au * ia;
            au = dpp_shr<2>(ia, 1.f); hu = dpp_shr<2>(ih, 0.f); ih = ia * hu + ih; ia = au * ia;
            au = dpp_shr<4>(ia, 1.f); hu = dpp_shr<4>(ih, 0.f); ih = ia * hu + ih; ia = au * ia;
            au = dpp_shr<8>(ia, 1.f); hu = dpp_shr<8>(ih, 0.f); ih = ia * hu + ih; ia = au * ia;
            ea[c] = dpp_shr<1>(ia, 1.f); eh[c] = dpp_shr<1>(ih, 0.f);
            pp[c] = ia; hh[c] = ih;
        }
        LAS float* xw = xch + (wc * 4 + fq) * 16;
        if (wr == 0 && fr == 15) {
#pragma unroll
            for (int c = 0; c < 8; ++c) { xw[2 * c] = pp[c]; xw[2 * c + 1] = hh[c]; }
        }
        asm volatile("s_waitcnt lgkmcnt(0)" ::: "memory");
        __builtin_amdgcn_s_barrier();
        asm volatile("" ::: "memory");
        if (wr == 1) {
#pragma unroll
            for (int c = 0; c < 8; ++c) {
                const float wa = xw[2 * c], wh = xw[2 * c + 1];
                if (fr == 15) { AT[(size_t)u.pm * D + ch + c] = wa * pp[c]; HT[(size_t)u.pm * D + ch + c] = pp[c] * wh + hh[c]; }
                eh[c] = ea[c] * wh + eh[c]; ea[c] = wa * ea[c];
            }
        }
#pragma unroll
        for (int ai = 0; ai < 2; ++ai)
#pragma unroll
            for (int m = 0; m < 4; ++m) {
                const unsigned off = ((unsigned)(tok0 + 4 * ai + m) * D + ch) * 2u;
                float hl[8], pc[8];
#pragma unroll
                for (int n = 0; n < 2; ++n)
#pragma unroll
                    for (int j = 0; j < 4; ++j) { const int c = 4 * n + j; hl[c] = acc[ai][0][m][n][j] + acc[ai][1][m][n][j] * eh[c]; pc[c] = acc[ai][1][m][n][j] * ea[c]; }
                u32x4 w0, w1;
                w0.x = cvt_pk_bf16(hl[0], hl[1]); w0.y = cvt_pk_bf16(hl[2], hl[3]); w0.z = cvt_pk_bf16(hl[4], hl[5]); w0.w = cvt_pk_bf16(hl[6], hl[7]);
                w1.x = cvt_pk_bf16(pc[0], pc[1]); w1.y = cvt_pk_bf16(pc[2], pc[3]); w1.z = cvt_pk_bf16(pc[4], pc[5]); w1.w = cvt_pk_bf16(pc[6], pc[7]);
                *(u32x4*)((char*)HL + off) = w0; *(u32x4*)((char*)PC + off) = w1;
            }
    }
};
struct EpiRes {
    const float* base; float* out; const float* gate;
    __device__ __forceinline__ void operator()(const f32x4 (&acc)[2][2][4][2], const pg8::Unit& u, int wr, int wc, int fr, int fq) const {
        const int row0 = u.pm * 256 + wr * 64 + fr, col0 = u.pn * 256 + wc * 32 + 4 * fq;
        const float* gp = gate + (size_t)(u.pm >> 5) * NMOD + col0;
        f32x4 gv[2][2];
#pragma unroll
        for (int bj = 0; bj < 2; ++bj)
#pragma unroll
            for (int n = 0; n < 2; ++n) gv[bj][n] = *(const f32x4*)(gp + bj * 128 + n * 16);
#pragma unroll
        for (int ai = 0; ai < 2; ++ai)
#pragma unroll
            for (int m = 0; m < 4; ++m) {
                const size_t off = (size_t)(row0 + ai * 128 + m * 16) * D + col0;
#pragma unroll
                for (int bj = 0; bj < 2; ++bj)
#pragma unroll
                    for (int n = 0; n < 2; ++n) { const f32x4 b = *(const f32x4*)(base + off + bj * 128 + n * 16); *(f32x4*)(out + off + bj * 128 + n * 16) = b + gv[bj][n] * acc[ai][bj][m][n]; }
            }
    }
};

template <int MODE, bool Q8 = false> struct EpiResNorm {
    const void* base; void* out; const float* gate; float* rowss; unsigned* cnt; const float* gvec; const float* modb; bf16_t* H; unsigned* rowmx; float* sa2; const float* shmax;
    __device__ __forceinline__ void operator()(f32x4 (&acc)[2][2][4][2], const pg8::Unit& u, int wr, int wc, int fr, int fq) const {
        const int row0 = u.pm * 256 + wr * 64 + fr, colb = u.pn * 256 + wc * 32 + 8 * fq;
        f32x4 gs[2][2], sh[2][2];
#pragma unroll
        for (int bj = 0; bj < 2; ++bj)
#pragma unroll
            for (int n = 0; n < 2; ++n) {
                if (MODE == 1) { gs[bj][n] = *(const f32x4*)(gvec + colb + bj * 128 + n * 4); sh[bj][n] = (f32x4){0.f, 0.f, 0.f, 0.f}; }
                else { const float* mb0 = modb + (size_t)(u.pm >> 5) * NMOD + colb;
                       gs[bj][n] = *(const f32x4*)(gvec + colb + bj * 128 + n * 4) * (*(const f32x4*)(mb0 + 4096 + bj * 128 + n * 4) + 1.0f); sh[bj][n] = *(const f32x4*)(mb0 + 3072 + bj * 128 + n * 4); }
            }
        {
            const float* gp = gate + (size_t)(u.pm >> 5) * NMOD + colb;
            f32x4 gv[2][2], gq[2][2], sq[2][2];
#pragma unroll
            for (int bj = 0; bj < 2; ++bj)
#pragma unroll
                for (int n = 0; n < 2; ++n) { gv[bj][n] = *(const f32x4*)(gp + bj * 128 + n * 4);
                    if (Q8) { gq[bj][n] = gs[bj][n]; sq[bj][n] = __builtin_elementwise_abs(sh[bj][n]); } }
#pragma unroll
            for (int ai = 0; ai < 2; ++ai)
#pragma unroll
                for (int m = 0; m < 4; ++m) {
                    const int row = row0 + ai * 128 + m * 16; const unsigned off = ((unsigned)row * D + colb) * 4u;
                    float ss = 0.f, mq = 0.f;
#pragma unroll
                    for (int bj = 0; bj < 2; ++bj) {
                        f32x4 b0, b1;
                        if (MODE == 0) { b0 = *(const f32x4*)((const char*)base + off + bj * 512); b1 = *(const f32x4*)((const char*)base + off + bj * 512 + 16); }
                        else { const u32x4 q = *(const u32x4*)((const char*)base + (off >> 1) + bj * 256); b0 = (f32x4){bf_lo(q.x), bf_hi(q.x), bf_lo(q.y), bf_hi(q.y)}; b1 = (f32x4){bf_lo(q.z), bf_hi(q.z), bf_lo(q.w), bf_hi(q.w)}; }
#pragma unroll
                        for (int n = 0; n < 2; ++n) { const f32x4 v = (n ? b1 : b0) + gv[bj][n] * acc[ai][bj][m][n];
                            acc[ai][bj][m][n] = v; ss += (v.x * v.x + v.y * v.y) + (v.z * v.z + v.w * v.w);
                            if (Q8) { const f32x4 t = __builtin_elementwise_abs(v * gq[bj][n]) + sq[bj][n]; mq = fmaxf(mq, fmaxf(fmaxf(t.x, t.y), fmaxf(t.z, t.w))); } }
                    }
                    ss += __shfl_xor(ss, 16); ss += __shfl_xor(ss, 32);
                    if (Q8) { mq = fmaxf(mq, __shfl_xor(mq, 16)); mq = fmaxf(mq, __shfl_xor(mq, 32)); }
                    if (fq == 0) { (void)__hip_atomic_fetch_add(rowss + row, ss, __ATOMIC_RELAXED, __HIP_MEMORY_SCOPE_AGENT);
                        if (Q8) (void)__hip_atomic_fetch_max(rowmx + row, __float_as_uint(mq), __ATOMIC_RELAXED, __HIP_MEMORY_SCOPE_AGENT); }
                }
        }
        asm volatile("s_waitcnt vmcnt(0)" ::: "memory");
        unsigned* cw = cnt + (2 * u.pm + wr) * 64;
        if (fr == 0 && fq == 0) (void)__hip_atomic_fetch_add(cw, 1u, __ATOMIC_RELAXED, __HIP_MEMORY_SCOPE_AGENT);
        { unsigned spins = 0;
          while ((unsigned)__builtin_amdgcn_readfirstlane(__hip_atomic_load(cw, __ATOMIC_RELAXED, __HIP_MEMORY_SCOPE_AGENT)) < 16u) { __builtin_amdgcn_s_sleep(1); if (++spins > (1u << 17)) break; } }
        asm volatile("" ::: "memory");
        float rs[2][4];
#pragma unroll
        for (int ai = 0; ai < 2; ++ai)
#pragma unroll
            for (int m = 0; m < 4; ++m) rs[ai][m] = rsqrtf(__hip_atomic_load(rowss + row0 + ai * 128 + m * 16, __ATOMIC_RELAXED, __HIP_MEMORY_SCOPE_AGENT) * (1.0f / D) + EPS);
        if (MODE == 1) {
#pragma unroll
            for (int ai = 0; ai < 2; ++ai)
#pragma unroll
                for (int m = 0; m < 4; ++m) {
                    const unsigned off = ((unsigned)(row0 + ai * 128 + m * 16) * D + colb) * 4u;
#pragma unroll
                    for (int bj = 0; bj < 2; ++bj)
#pragma unroll
                        for (int n = 0; n < 2; ++n) *(f32x4*)((char*)out + off + bj * 512 + n * 16) = acc[ai][bj][m][n] * rs[ai][m] * gs[bj][n];
                }
        } else {
            float qinv[2][4];
            if (Q8) { const float shm = shmax[u.pm >> 5];
#pragma unroll
                for (int ai = 0; ai < 2; ++ai)
#pragma unroll
                    for (int m = 0; m < 4; ++m) { const int row = row0 + ai * 128 + m * 16;
                        const float bound = rs[ai][m] * __uint_as_float(__hip_atomic_load(rowmx + row, __ATOMIC_RELAXED, __HIP_MEMORY_SCOPE_AGENT)) + fmaxf(0.0f, 1.0f - rs[ai][m]) * shm;
                        qinv[ai][m] = bound > 0.f ? 127.0f / bound : 0.f;
                        if (u.pn == 0 && wc == 0 && fq == 0) sa2[row] = bound * (1.0f / 127.0f); } }
#pragma unroll
            for (int ai = 0; ai < 2; ++ai)
#pragma unroll
                for (int m = 0; m < 4; ++m) {
                    const unsigned off = ((unsigned)(row0 + ai * 128 + m * 16) * D + colb) * 4u;
#pragma unroll
                    for (int bj = 0; bj < 2; ++bj) {
                        const f32x4 v0 = acc[ai][bj][m][0], v1 = acc[ai][bj][m][1];
                        u32x4 xw; xw.x = cvt_pk_bf16(v0.x, v0.y); xw.y = cvt_pk_bf16(v0.z, v0.w); xw.z = cvt_pk_bf16(v1.x, v1.y); xw.w = cvt_pk_bf16(v1.z, v1.w);
                        *(u32x4*)((char*)out + (off >> 1) + bj * 256) = xw;
                        const f32x4 y0 = v0 * rs[ai][m] * gs[bj][0] + sh[bj][0], y1 = v1 * rs[ai][m] * gs[bj][1] + sh[bj][1];
                        if (Q8) { const f32x4 q0 = y0 * qinv[ai][m], q1 = y1 * qinv[ai][m];
                            const int a0 = (int)__builtin_rintf(q0.x), a1 = (int)__builtin_rintf(q0.y), a2 = (int)__builtin_rintf(q0.z), a3 = (int)__builtin_rintf(q0.w);
                            const int c0 = (int)__builtin_rintf(q1.x), c1 = (int)__builtin_rintf(q1.y), c2 = (int)__builtin_rintf(q1.z), c3 = (int)__builtin_rintf(q1.w);
                            u32x2 w; w.x = (unsigned)(a0 & 0xff) | ((unsigned)(a1 & 0xff) << 8) | ((unsigned)(a2 & 0xff) << 16) | ((unsigned)a3 << 24);
                            w.y = (unsigned)(c0 & 0xff) | ((unsigned)(c1 & 0xff) << 8) | ((unsigned)(c2 & 0xff) << 16) | ((unsigned)c3 << 24);
                            *(u32x2*)((char*)H + (off >> 2) + bj * 128) = w; }
                        else { u32x4 w; w.x = cvt_pk_bf16(y0.x, y0.y); w.y = cvt_pk_bf16(y0.z, y0.w); w.z = cvt_pk_bf16(y1.x, y1.y); w.w = cvt_pk_bf16(y1.z, y1.w); *(u32x4*)((char*)H + (off >> 1) + bj * 256) = w; }
                    }
                }
        }
    }
};
struct EpiConvA {
    bf16_t* YA; bf16_t* PT; bf16_t* ST; const float* cw;
    __device__ __forceinline__ void operator()(f32x4 (&acc)[2][2][4][2], const pg8::Unit& u, int wr, int wc, int fr, int fq) const {
        const int ch = u.pn * 64 + wc * 16 + fq * 4, tok0 = u.pm * 256 + 8 * (fr + 16 * wr), hb = 2 * u.pm + wr;
        const f32x4 w0 = *(const f32x4*)(cw + ch), w1 = *(const f32x4*)(cw + D + ch), w2 = *(const f32x4*)(cw + 2 * D + ch);
#pragma unroll
        for (int ai = 0; ai < 2; ++ai)
#pragma unroll
            for (int m = 0; m < 4; ++m) {
                const f32x4 cb = acc[ai][0][m][0], cc = acc[ai][0][m][1], cx = acc[ai][1][m][0], ga = acc[ai][1][m][1];
                f32x4 sv;
#pragma unroll
                for (int j = 0; j < 4; ++j) sv[j] = sigm(ga[j]) * cb[j];
                acc[ai][0][m][0] = sv; acc[ai][0][m][1] = cc * cx;
            }
        const f32x4 p6 = acc[1][0][2][1], p7 = acc[1][0][3][1];
        f32x4 a, b;
#pragma unroll
        for (int j = 0; j < 4; ++j) { a[j] = dpp_shr<1>(p6[j], 0.f); b[j] = dpp_shr<1>(p7[j], 0.f); }
        if (fr == 15) { u32x2 q6, q7; q6.x = cvt_pk_bf16(p6.x, p6.y); q6.y = cvt_pk_bf16(p6.z, p6.w); q7.x = cvt_pk_bf16(p7.x, p7.y); q7.y = cvt_pk_bf16(p7.z, p7.w);
            *(u32x2*)(PT + (size_t)(hb * 2 + 0) * D + ch) = q6; *(u32x2*)(PT + (size_t)(hb * 2 + 1) * D + ch) = q7; }
        if (fr == 0) { const f32x4 s0 = acc[0][0][0][0], s1 = acc[0][0][1][0]; u32x2 q0, q1; q0.x = cvt_pk_bf16(s0.x, s0.y); q0.y = cvt_pk_bf16(s0.z, s0.w); q1.x = cvt_pk_bf16(s1.x, s1.y); q1.y = cvt_pk_bf16(s1.z, s1.w);
            *(u32x2*)(ST + (size_t)(hb * 2 + 0) * D + ch) = q0; *(u32x2*)(ST + (size_t)(hb * 2 + 1) * D + ch) = q1; }
#pragma unroll
        for (int ai = 0; ai < 2; ++ai)
#pragma unroll
            for (int m = 0; m < 4; ++m) {
                const f32x4 pc = acc[ai][0][m][1], y = acc[ai][0][m][0] * (w0 * a + w1 * b + w2 * pc);
                u32x2 w; w.x = cvt_pk_bf16(y.x, y.y); w.y = cvt_pk_bf16(y.z, y.w);
                *(u32x2*)((char*)YA + ((unsigned)(tok0 + 4 * ai + m) * D + ch) * 2u) = w;
                a = b; b = pc;
            }
    }
};

struct EpiConvC {
    const float* sa; const float* sb; bf16_t* U; bf16_t* RXS; const float* cw; const float* cbias;
    __device__ __forceinline__ void operator()(const i32x4 (&acc)[2][2][4][2], const pg8::Unit& u, int wr, int wc, int fr, int fq) const {
        const int tok0 = u.pm * 256 + 8 * (fr + 16 * wr), hb = 2 * u.pm + wr, col0 = u.pn * 256 + wc * 32 + 4 * fq;
        float sav[8];
#pragma unroll
        for (int i = 0; i < 8; ++i) sav[i] = sa[tok0 + i];
#pragma unroll
        for (int bj = 0; bj < 2; ++bj) {
            u32x2 vq[8];
#pragma unroll
            for (int n = 0; n < 2; ++n) {
                __builtin_amdgcn_sched_barrier(0);
                const int ch = u.pn * 256 + bj * 128 + wc * 32 + fq * 8 + 4 * n;
                const f32x4 sbn = *(const f32x4*)(sb + col0 + bj * 128 + n * 16);
                const f32x4 w0 = *(const f32x4*)(cw + ch), w1 = *(const f32x4*)(cw + D + ch), w2 = *(const f32x4*)(cw + 2 * D + ch), w3 = *(const f32x4*)(cw + 3 * D + ch), bb = *(const f32x4*)(cbias + ch);
                f32x4 r[8];
#pragma unroll
                for (int ai = 0; ai < 2; ++ai)
#pragma unroll
                    for (int m = 0; m < 4; ++m) { const i32x4 q = acc[ai][bj][m][n]; r[4 * ai + m] = (f32x4){(float)q.x, (float)q.y, (float)q.z, (float)q.w} * sbn * sav[4 * ai + m]; }
                f32x4 pv[3];
#pragma unroll
                for (int k = 0; k < 3; ++k)
#pragma unroll
                    for (int j = 0; j < 4; ++j) pv[k][j] = dpp_shr<1>(r[5 + k][j], 0.f);
                if (fr == 0 || fr == 15) {
#pragma unroll
                    for (int k = 0; k < 3; ++k) { const f32x4 x = (fr == 0) ? r[k] : r[5 + k]; u32x2 q; q.x = cvt_pk_bf16(x.x, x.y); q.y = cvt_pk_bf16(x.z, x.w);
                        *(u32x2*)(RXS + (size_t)(hb * 6 + (fr == 0 ? k : 3 + k)) * D + ch) = q; }
                }
#pragma unroll
                for (int i = 0; i < 8; ++i) {
                    const f32x4 x3 = (i >= 3) ? r[i >= 3 ? i - 3 : 0] : pv[i >= 3 ? 0 : i];
                    const f32x4 x2 = (i >= 2) ? r[i >= 2 ? i - 2 : 0] : pv[i >= 2 ? 0 : i + 1];
                    const f32x4 x1 = (i >= 1) ? r[i >= 1 ? i - 1 : 0] : pv[2];
                    const f32x4 v = bb + w0 * x3 + w1 * x2 + w2 * x1 + w3 * r[i];
                    u32x2 q; q.x = cvt_pk_bf16(v.x, v.y); q.y = cvt_pk_bf16(v.z, v.w);
                    if (n == 0) vq[i] = q;
                    else *(u32x4*)((char*)U + ((unsigned)(tok0 + i) * D + ch - 4) * 2u) = (u32x4){vq[i].x, vq[i].y, q.x, q.y};
                }
            }
        }
    }
};

struct EpiRG3 {
    const bf16_t* U; bf16_t* MERGED; unsigned long long* TOT; unsigned* FLAG; const float* ba; const float* bx; const float* ls8; LAS float* xch;
    const bf16_t* YA; const bf16_t* G2; const bf16_t* PT; const bf16_t* ST; const float* cw;
    __device__ __forceinline__ void operator()(f32x4 (&acc)[2][2][4][2], const pg8::Unit& u, int wr, int wc, int fr_, int fq_) const {
        int fr = fr_, fq = fq_; asm volatile("" : "+v"(fr), "+v"(fq));
        const int ch = u.pn * 128 + wc * 32 + fq * 8, tok0 = u.pm * 256 + 8 * (fr + 16 * wr);
        float hh[8], pp[8];
        {
            f32x4 ba4[2], bx4[2], ls4[2];
#pragma unroll
            for (int n = 0; n < 2; ++n) { ba4[n] = *(const f32x4*)((const char*)ba + (unsigned)(ch + 4 * n) * 4u) * -1.4426950408889634f; bx4[n] = *(const f32x4*)((const char*)bx + (unsigned)(ch + 4 * n) * 4u) * -1.4426950408889634f; ls4[n] = *(const f32x4*)((const char*)ls8 + (unsigned)(ch + 4 * n) * 4u) * 1.4426950408889634f; }
#pragma unroll
            for (int c = 0; c < 8; ++c) { hh[c] = 0.f; pp[c] = 1.f; }
            u32x4 uq[8];
#pragma unroll
            for (int i = 0; i < 8; ++i) uq[i] = *(const u32x4*)((const char*)U + ((unsigned)(tok0 + i) * D + ch) * 2u);
#pragma unroll
            for (int ai = 0; ai < 2; ++ai)
#pragma unroll
                for (int m = 0; m < 4; ++m) {
                    __builtin_amdgcn_sched_barrier(0);
                    const int row = tok0 + 4 * ai + m; const bool first = (row & (SEQ - 1)) == 0;
                    const u32x4 uu = uq[4 * ai + m];
                    const float uf[8] = {bf_lo(uu.x), bf_hi(uu.x), bf_lo(uu.y), bf_hi(uu.y), bf_lo(uu.z), bf_hi(uu.z), bf_lo(uu.w), bf_hi(uu.w)};
#pragma unroll
                    for (int n = 0; n < 2; ++n)
#pragma unroll
                        for (int j = 0; j < 4; ++j) {
                            const int c = 4 * n + j;
                            const float r = __builtin_amdgcn_rcpf(1.0f + __builtin_amdgcn_exp2f(__builtin_fmaf(acc[ai][0][m][n][j], -1.4426950408889634f, ba4[n][j])));
                            const float ig = __builtin_amdgcn_rcpf(1.0f + __builtin_amdgcn_exp2f(__builtin_fmaf(acc[ai][1][m][n][j], -1.4426950408889634f, bx4[n][j])));
                            const float a = __builtin_amdgcn_exp2f(r * ls4[n][j]);
                            float mult = __builtin_amdgcn_sqrtf(__builtin_fmaf(-a, a, 1.0f));
                            if (ai == 0 && m == 0) mult = first ? 1.0f : mult;
                            hh[c] = a * hh[c] + mult * ig * uf[c]; pp[c] *= a;
                            acc[ai][0][m][n][j] = hh[c]; acc[ai][1][m][n][j] = pp[c];
                        }
                }
        }
        __builtin_amdgcn_sched_barrier(0);
        float ea[8], eh[8];
#pragma unroll
        for (int c = 0; c < 8; ++c) {
            float ia = pp[c], ih = hh[c], au, hu;
            au = dpp_shr<1>(ia, 1.f); hu = dpp_shr<1>(ih, 0.f); ih = ia * hu + ih; ia = au * ia;
            au = dpp_shr<2>(ia, 1.f); hu = dpp_shr<2>(ih, 0.f); ih = ia * hu + ih; ia = au * ia;
            au = dpp_shr<4>(ia, 1.f); hu = dpp_shr<4>(ih, 0.f); ih = ia * hu + ih; ia = au * ia;
            au = dpp_shr<8>(ia, 1.f); hu = dpp_shr<8>(ih, 0.f); ih = ia * hu + ih; ia = au * ia;
            ea[c] = dpp_shr<1>(ia, 1.f); eh[c] = dpp_shr<1>(ih, 0.f);
            pp[c] = ia; hh[c] = ih;
        }
        LAS float* xw = xch + (wc * 4 + fq) * 16;
        if (wr == 0 && fr == 15) {
#pragma unroll
            for (int c = 0; c < 8; ++c) { xw[2 * c] = pp[c]; xw[2 * c + 1] = hh[c]; }
        }
        asm volatile("s_waitcnt lgkmcnt(0)" ::: "memory");
        __builtin_amdgcn_s_barrier();
        asm volatile("" ::: "memory");
        if (wr == 1) {
#pragma unroll
            for (int c = 0; c < 8; ++c) {
                const float wa = xw[2 * c], wh = xw[2 * c + 1];
                if (fr == 15) { const float ta = wa * pp[c], th = pp[c] * wh + hh[c];
                    __hip_atomic_store((unsigned long long*)((char*)TOT + ((unsigned)(u.pm * D + ch + c)) * 8u), ((unsigned long long)__float_as_uint(th) << 32) | __float_as_uint(ta), __ATOMIC_RELAXED, __HIP_MEMORY_SCOPE_AGENT); }
                eh[c] = ea[c] * wh + eh[c]; ea[c] = wa * ea[c];
            }
            asm volatile("s_waitcnt vmcnt(0)" ::: "memory");
            if (fr == 15 && fq == 0) (void)__hip_atomic_fetch_add((unsigned*)((char*)FLAG + (unsigned)(u.pm * 8 + u.pn) * 4u), 1u, __ATOMIC_RELAXED, __HIP_MEMORY_SCOPE_AGENT);
        }
        __builtin_amdgcn_sched_barrier(0);
        {
            const int kb = u.pm & 31;
            float ca[8], chh[8];
#pragma unroll
            for (int c = 0; c < 8; ++c) { ca[c] = 1.f; chh[c] = 0.f; }
#pragma unroll
            for (int q = 0; q < 2; ++q) {
                const int pidx = 2 * fr + q;
                if (pidx < kb) {
                    const int k = u.pm - kb + pidx; unsigned spins = 0;
                    while (__hip_atomic_load((const unsigned*)((const char*)FLAG + (unsigned)(k * 8 + u.pn) * 4u), __ATOMIC_RELAXED, __HIP_MEMORY_SCOPE_AGENT) < 4u) { __builtin_amdgcn_s_sleep(1); if (++spins > (1u << 16)) break; }
#pragma unroll
                    for (int c = 0; c < 8; ++c) { const unsigned long long w = __hip_atomic_load((const unsigned long long*)((const char*)TOT + ((unsigned)(k * D + ch + c)) * 8u), __ATOMIC_RELAXED, __HIP_MEMORY_SCOPE_AGENT);
                        const float ta = __uint_as_float((unsigned)w), th = __uint_as_float((unsigned)(w >> 32)); chh[c] = ta * chh[c] + th; ca[c] = ta * ca[c]; }
                }
            }
#pragma unroll
            for (int c = 0; c < 8; ++c) {
                float ia = ca[c], ih = chh[c], au, hu;
                au = dpp_shr<1>(ia, 1.f); hu = dpp_shr<1>(ih, 0.f); ih = ia * hu + ih; ia = au * ia;
                au = dpp_shr<2>(ia, 1.f); hu = dpp_shr<2>(ih, 0.f); ih = ia * hu + ih; ia = au * ia;
                au = dpp_shr<4>(ia, 1.f); hu = dpp_shr<4>(ih, 0.f); ih = ia * hu + ih; ia = au * ia;
                au = dpp_shr<8>(ia, 1.f); hu = dpp_shr<8>(ih, 0.f); ih = ia * hu + ih; ia = au * ia;
                const float carry = __shfl(ih, fq * 16 + 15);
                eh[c] = __builtin_fmaf(ea[c], carry, eh[c]);
            }
        }
        __builtin_amdgcn_sched_barrier(0);
        u32x4 qy[4], qg[4];
#pragma unroll
        for (int i = 0; i < 4; ++i) { const unsigned off = ((unsigned)(tok0 + i) * D + ch) * 2u; qy[i] = *(const u32x4*)((const char*)YA + off); qg[i] = *(const u32x4*)((const char*)G2 + off); }
#pragma unroll
        for (int half = 0; half < 2; ++half) {
            __builtin_amdgcn_sched_barrier(0);
            u32x4 ny[4], ng[4];
            if (half == 0) {
#pragma unroll
                for (int i = 0; i < 4; ++i) { const unsigned off = ((unsigned)(tok0 + 4 + i) * D + ch) * 2u; ny[i] = *(const u32x4*)((const char*)YA + off); ng[i] = *(const u32x4*)((const char*)G2 + off); }
            }
#pragma unroll
            for (int m = 0; m < 4; ++m) {
                const int ai = half, i = 4 * ai + m; const unsigned off = ((unsigned)(tok0 + i) * D + ch) * 2u;
                const unsigned yw[4] = {qy[m].x, qy[m].y, qy[m].z, qy[m].w}, gw4[4] = {qg[m].x, qg[m].y, qg[m].z, qg[m].w};
                unsigned ow[4];
#pragma unroll
                for (int q = 0; q < 4; ++q) {
                    const int c0 = 2 * q, c1 = 2 * q + 1, n0 = c0 >> 2, j0 = c0 & 3, n1 = c1 >> 2, j1 = c1 & 3;
                    const float h0 = acc[ai][0][m][n0][j0] + acc[ai][1][m][n0][j0] * eh[c0], h1 = acc[ai][0][m][n1][j1] + acc[ai][1][m][n1][j1] * eh[c1];
                    float m0 = bf_lo(yw[q]) + h0 * bf_lo(gw4[q]), m1 = bf_hi(yw[q]) + h1 * bf_hi(gw4[q]);
                    ow[q] = cvt_pk_bf16(m0, m1);
                }
                *(u32x4*)((char*)MERGED + off) = (u32x4){ow[0], ow[1], ow[2], ow[3]};
            }
            if (half == 0) {
#pragma unroll
                for (int i = 0; i < 4; ++i) { qy[i] = ny[i]; qg[i] = ng[i]; }
            }
        }
    }
};
struct EpiGU {
    bf16_t* ACT;
    __device__ __forceinline__ void operator()(const f32x4 (&acc)[2][2][4][2], const pg8::Unit& u, int wr, int wc, int fr, int fq) const {
        const int row0 = u.pm * 256 + wr * 64 + fr, ch = u.pn * 128 + wc * 32 + fq * 8;
#pragma unroll
        for (int ai = 0; ai < 2; ++ai)
#pragma unroll
            for (int m = 0; m < 4; ++m) {
                const size_t off = (size_t)(row0 + ai * 128 + m * 16) * FF + ch;
                float v[8];
#pragma unroll
                for (int n = 0; n < 2; ++n)
#pragma unroll
                    for (int j = 0; j < 4; ++j) { const float g = acc[ai][0][m][n][j]; v[4 * n + j] = g * sigm(g) * acc[ai][1][m][n][j]; }
                u32x4 w; w.x = cvt_pk_bf16(v[0], v[1]); w.y = cvt_pk_bf16(v[2], v[3]); w.z = cvt_pk_bf16(v[4], v[5]); w.w = cvt_pk_bf16(v[6], v[7]);
                *(u32x4*)(ACT + off) = w;
            }
    }
};

__device__ __forceinline__ int map_in(int n) {
    const int q = n >> 10, ch = n & 1023;
    if (q == 3) return 6144 + (ch & ~127) + slot8(ch & 127);
    if (q == 4 || q == 6) return 4096 + (ch >> 7) * 256 + (q == 6 ? 128 : 0) + slot8(ch & 127);
    const int s = (q == 5) ? 3 : q;
    return (ch >> 6) * 256 + 128 * (s >> 1) + 32 * ((ch >> 4) & 3) + 16 * (s & 1) + (ch & 15);
}
__device__ __forceinline__ int map_gu(int n) { const int s = n >= FF ? 1 : 0, ch = n - s * FF; return (ch >> 7) * 256 + 128 * s + slot8(ch & 127); }
__device__ __forceinline__ int map_rg(int h, int s, int jc) { return (2 * h + (jc >> 7)) * 256 + 128 * s + slot8(jc & 127); }

__device__ __forceinline__ void tr_item(const float* src, int ldn, int k0, int n0, bf16_t* dst, int ldk, LAS float* scr, int lane, int kind, int aux) {
    float tv[32];
#pragma unroll
    for (int i = 0; i < 32; ++i) { const int kk = 2 * i + (lane >> 5); tv[i] = src[(size_t)(k0 + kk) * ldn + n0 + (lane & 31)]; }
#pragma unroll
    for (int i = 0; i < 32; ++i) { const int kk = 2 * i + (lane >> 5); scr[kk * 33 + (lane & 31)] = tv[i]; }
    asm volatile("s_waitcnt lgkmcnt(0)" ::: "memory");
    const int kp = lane & 31;
#pragma unroll 4
    for (int i = 0; i < 16; ++i) {
        const int jn = 2 * i + (lane >> 5), n = n0 + jn;
        const float v0 = scr[(2 * kp) * 33 + jn], v1 = scr[(2 * kp + 1) * 33 + jn];
        int row;
        if (kind == 0) row = map_in(n); else if (kind == 1) row = map_gu(n); else if (kind == 2) row = (n & ~127) | slot8(n & 127); else row = map_rg(aux >> 1, aux & 1, n);
        *(unsigned*)(dst + (size_t)row * ldk + k0 + 2 * kp) = cvt_pk_bf16(v0, v1);
    }
    asm volatile("s_waitcnt lgkmcnt(0)" ::: "memory");
}

__device__ __forceinline__ void norm_rows_bf16(const float* X, const float* g, const float* mod, int shoff, int scoff, bf16_t* H, int gw, int NGW, int lane) {
    for (int row = gw; row < M; row += NGW) {
        const float* mb = mod + (size_t)(row >> 13) * NMOD;
        const f32x4* xr = (const f32x4*)(X + (size_t)row * D) + lane;
        f32x4 v[4]; float s = 0.f;
#pragma unroll
        for (int j = 0; j < 4; ++j) { v[j] = xr[64 * j]; s += (v[j].x * v[j].x + v[j].y * v[j].y) + (v[j].z * v[j].z + v[j].w * v[j].w); }
        const float rstd = rsqrtf(wave_sum(s) * (1.0f / D) + EPS);
        u32x2* o = (u32x2*)(H + (size_t)row * D) + lane;
#pragma unroll
        for (int j = 0; j < 4; ++j) {
            const int col = 4 * (lane + 64 * j);
            const f32x4 g4 = *(const f32x4*)(g + col), sc4 = *(const f32x4*)(mb + scoff + col), sh4 = *(const f32x4*)(mb + shoff + col);
            const f32x4 y = v[j] * rstd * g4 * (sc4 + 1.0f) + sh4;
            u32x2 w; w.x = cvt_pk_bf16(y.x, y.y); w.y = cvt_pk_bf16(y.z, y.w); o[64 * j] = w;
        }
    }
}


__device__ __forceinline__ void amax_item(const float* src, int ldn, int k0, int n0, unsigned* cmax, int lane) {
    float mx = 0.f;
#pragma unroll
    for (int i = 0; i < 32; ++i) { const int kk = 2 * i + (lane >> 5); mx = fmaxf(mx, fabsf(src[(size_t)(k0 + kk) * ldn + n0 + (lane & 31)])); }
    mx = fmaxf(mx, __shfl_xor(mx, 32));
    if (lane < 32) (void)__hip_atomic_fetch_max(cmax + n0 + lane, __float_as_uint(mx), __ATOMIC_RELAXED, __HIP_MEMORY_SCOPE_AGENT);
}
__device__ __forceinline__ void q_item(const float* src, int ldn, int k0, int n0, signed char* dst, int ldk, unsigned* cmax, float* sb, LAS float* scr, int lane, int kind) {
    float tv[32];
#pragma unroll
    for (int i = 0; i < 32; ++i) { const int kk = 2 * i + (lane >> 5); tv[i] = src[(size_t)(k0 + kk) * ldn + n0 + (lane & 31)]; }
#pragma unroll
    for (int i = 0; i < 32; ++i) { const int kk = 2 * i + (lane >> 5); scr[kk * 33 + (lane & 31)] = tv[i]; }
    asm volatile("s_waitcnt lgkmcnt(0)" ::: "memory");
    const int kq = lane & 15;
#pragma unroll 2
    for (int i = 0; i < 8; ++i) {
        const int jn = 4 * i + (lane >> 4), n = n0 + jn;
        const float cm = __uint_as_float(__hip_atomic_load(cmax + n, __ATOMIC_RELAXED, __HIP_MEMORY_SCOPE_AGENT));
        const float inv = cm > 0.f ? 127.0f / cm : 0.f;
        const int q0 = (int)__builtin_rintf(scr[(4 * kq + 0) * 33 + jn] * inv), q1 = (int)__builtin_rintf(scr[(4 * kq + 1) * 33 + jn] * inv),
                  q2 = (int)__builtin_rintf(scr[(4 * kq + 2) * 33 + jn] * inv), q3 = (int)__builtin_rintf(scr[(4 * kq + 3) * 33 + jn] * inv);
        const int row = (kind == 0) ? map_in(n) : (kind == 1 ? map_gu(n) : map_in(n) - 4096);
        *(unsigned*)(dst + (size_t)row * ldk + k0 + 4 * kq) = (unsigned)(q0 & 0xff) | ((unsigned)(q1 & 0xff) << 8) | ((unsigned)(q2 & 0xff) << 16) | ((unsigned)q3 << 24);
        if (k0 == 0 && kq == 0) sb[row] = cm * (1.0f / 127.0f);
    }
    asm volatile("s_waitcnt lgkmcnt(0)" ::: "memory");
}
__device__ __forceinline__ float wave_max(float v) {
#pragma unroll
    for (int o = 32; o >= 1; o >>= 1) v = fmaxf(v, __shfl_xor(v, o));
    return v;
}
__device__ __forceinline__ void norm_rows_i8(const float* X, const float* g, const float* mod, int shoff, int scoff, signed char* Hq, float* sa, bf16_t* Hb, int gw, int NGW, int lane) {
    f32x4 nv[4];
    if (gw < M) { const f32x4* xr = (const f32x4*)(X + (size_t)gw * D) + lane;
#pragma unroll
        for (int j = 0; j < 4; ++j) nv[j] = xr[64 * j]; }
    int cur_b = -1; f32x4 gs[4], shv[4];
    for (int row = gw; row < M; row += NGW) {
        f32x4 v[4]; float s = 0.f;
#pragma unroll
        for (int j = 0; j < 4; ++j) { v[j] = nv[j]; s += (v[j].x * v[j].x + v[j].y * v[j].y) + (v[j].z * v[j].z + v[j].w * v[j].w); }
        if (row + NGW < M) { const f32x4* xr = (const f32x4*)(X + (size_t)(row + NGW) * D) + lane;
#pragma unroll
            for (int j = 0; j < 4; ++j) nv[j] = xr[64 * j]; }
        const int b = row >> 13;
        if (b != cur_b) { cur_b = b; const float* mb = mod + (size_t)b * NMOD;
#pragma unroll
            for (int j = 0; j < 4; ++j) { const int col = 4 * (lane + 64 * j); gs[j] = *(const f32x4*)(g + col) * (*(const f32x4*)(mb + scoff + col) + 1.0f); shv[j] = *(const f32x4*)(mb + shoff + col); } }
        const float rstd = rsqrtf(wave_sum(s) * (1.0f / D) + EPS);
        float mx = 0.f;
#pragma unroll
        for (int j = 0; j < 4; ++j) {
            v[j] = v[j] * rstd * gs[j] + shv[j];
            mx = fmaxf(mx, fmaxf(fmaxf(fabsf(v[j].x), fabsf(v[j].y)), fmaxf(fabsf(v[j].z), fabsf(v[j].w))));
        }
        mx = wave_max(mx);
        const float inv = mx > 0.f ? 127.0f / mx : 0.f;
        unsigned* o = (unsigned*)(Hq + (size_t)row * D) + lane;
#pragma unroll
        for (int j = 0; j < 4; ++j) {
            const int q0 = (int)__builtin_rintf(v[j].x * inv), q1 = (int)__builtin_rintf(v[j].y * inv), q2 = (int)__builtin_rintf(v[j].z * inv), q3 = (int)__builtin_rintf(v[j].w * inv);
            o[64 * j] = (unsigned)(q0 & 0xff) | ((unsigned)(q1 & 0xff) << 8) | ((unsigned)(q2 & 0xff) << 16) | ((unsigned)q3 << 24);
            if (Hb) { u32x2 w; w.x = cvt_pk_bf16(v[j].x, v[j].y); w.y = cvt_pk_bf16(v[j].z, v[j].w); ((u32x2*)(Hb + (size_t)row * D) + lane)[64 * j] = w; }
        }
        if (lane == 0) sa[row] = mx * (1.0f / 127.0f);
    }
}

__device__ __forceinline__ void conv_fix_item(int hb, int c8, bool doU, bool doYA, const float* conv_b_w, const float* conv_b_bias, const float* conv_a_w, const bf16_t* RXS, bf16_t* U, bf16_t* YA, const bf16_t* PT, const bf16_t* ST) {
    const int t0 = hb * 128;
    if (doU) {
        u32x4 x[6];
#pragma unroll
        for (int k = 0; k < 3; ++k) { x[k] = *(const u32x4*)(RXS + (size_t)((hb - 1) * 6 + 3 + k) * D + c8); x[3 + k] = *(const u32x4*)(RXS + (size_t)(hb * 6 + k) * D + c8); }
        float w[4][8], bb[8];
#pragma unroll
        for (int k = 0; k < 4; ++k)
#pragma unroll
            for (int j = 0; j < 8; ++j) w[k][j] = conv_b_w[k * D + c8 + j];
#pragma unroll
        for (int j = 0; j < 8; ++j) bb[j] = conv_b_bias[c8 + j];
#pragma unroll
        for (int o = 0; o < 3; ++o) {
            float v[8];
#pragma unroll
            for (int j = 0; j < 8; ++j) v[j] = bb[j];
#pragma unroll
            for (int k = 0; k < 4; ++k) { const u32x4 q = x[o + k];
                v[0] += w[k][0] * bf_lo(q.x); v[1] += w[k][1] * bf_hi(q.x); v[2] += w[k][2] * bf_lo(q.y); v[3] += w[k][3] * bf_hi(q.y);
                v[4] += w[k][4] * bf_lo(q.z); v[5] += w[k][5] * bf_hi(q.z); v[6] += w[k][6] * bf_lo(q.w); v[7] += w[k][7] * bf_hi(q.w); }
            u32x4 wv; wv.x = cvt_pk_bf16(v[0], v[1]); wv.y = cvt_pk_bf16(v[2], v[3]); wv.z = cvt_pk_bf16(v[4], v[5]); wv.w = cvt_pk_bf16(v[6], v[7]);
            *(u32x4*)(U + (size_t)(t0 + o) * D + c8) = wv;
        }
    }
    if (doYA) {
        const u32x4 s0 = *(const u32x4*)(ST + (size_t)(hb * 2 + 0) * D + c8), s1 = *(const u32x4*)(ST + (size_t)(hb * 2 + 1) * D + c8);
        const u32x4 pa = *(const u32x4*)(PT + (size_t)((hb - 1) * 2 + 0) * D + c8), pb = *(const u32x4*)(PT + (size_t)((hb - 1) * 2 + 1) * D + c8);
        const u32x4 y0 = *(const u32x4*)(YA + (size_t)t0 * D + c8), y1 = *(const u32x4*)(YA + (size_t)(t0 + 1) * D + c8);
        const unsigned s0w[4] = {s0.x, s0.y, s0.z, s0.w}, s1w[4] = {s1.x, s1.y, s1.z, s1.w}, paw[4] = {pa.x, pa.y, pa.z, pa.w}, pbw[4] = {pb.x, pb.y, pb.z, pb.w}, y0w[4] = {y0.x, y0.y, y0.z, y0.w}, y1w[4] = {y1.x, y1.y, y1.z, y1.w};
        unsigned o0[4], o1[4];
#pragma unroll
        for (int q = 0; q < 4; ++q) {
            const int j0 = 2 * q, j1 = 2 * q + 1;
            const float w00 = conv_a_w[c8 + j0], w01 = conv_a_w[c8 + j1], w10 = conv_a_w[D + c8 + j0], w11 = conv_a_w[D + c8 + j1];
            o0[q] = cvt_pk_bf16(bf_lo(y0w[q]) + bf_lo(s0w[q]) * (w00 * bf_lo(paw[q]) + w10 * bf_lo(pbw[q])), bf_hi(y0w[q]) + bf_hi(s0w[q]) * (w01 * bf_hi(paw[q]) + w11 * bf_hi(pbw[q])));
            o1[q] = cvt_pk_bf16(bf_lo(y1w[q]) + bf_lo(s1w[q]) * (w00 * bf_lo(pbw[q])), bf_hi(y1w[q]) + bf_hi(s1w[q]) * (w01 * bf_hi(pbw[q])));
        }
        *(u32x4*)(YA + (size_t)t0 * D + c8) = (u32x4){o0[0], o0[1], o0[2], o0[3]}; *(u32x4*)(YA + (size_t)(t0 + 1) * D + c8) = (u32x4){o1[0], o1[1], o1[2], o1[3]};
    }
}

struct Params { const float* in[19]; float* out; unsigned char* ws; };

__global__ void __launch_bounds__(512, 2) fwd_megakernel(Params P) {
    extern __shared__ __attribute__((aligned(16))) unsigned char lds_raw[];
    LAS unsigned char* lds = (LAS unsigned char*)lds_raw;
    cg::grid_group grid = cg::this_grid();
    const int G = gridDim.x, bid = blockIdx.x;
    const int cid = (G == 256) ? ((bid & 31) * 8 + (bid >> 5)) : bid;
#define KARG(i) ({ const __attribute__((address_space(4))) char* _k = (const __attribute__((address_space(4))) char*)__builtin_amdgcn_kernarg_segment_ptr(); asm volatile("" : "+s"(_k)); *(const float* const __attribute__((address_space(4)))*)(_k + 8 * (i)); })
#define PHASE_IDS() int tid = threadIdx.x; asm volatile("" : "+v"(tid)); const int lane = tid & 63, wave = __builtin_amdgcn_readfirstlane(tid >> 6), gw = bid * 8 + wave, NGW = G * 8; (void)lane; (void)gw; (void)NGW
#define WSP(T, off) ((T*)((unsigned char*)KARG(20) + (off)))
#define OUTP ((float*)KARG(19))
#define GRID_BAR() do { XcdBarrier _b; _b.bar = WSP(unsigned, WS_BAR); _b.x = xb_xcc_id(); _b.st = (volatile LAS unsigned*)(lds + 131072); xcd_barrier(_b); } while (0)
    if (threadIdx.x < 4) ((LAS unsigned*)(lds + 131072))[threadIdx.x] = 0u;
    __syncthreads();
    xcd_barrier_post(WSP(unsigned, WS_BAR));
    for (int pass = 0; pass < NPASS; ++pass) {
    for (int rep = 0; rep < REP0; ++rep)
    {
        PHASE_IDS();
        const float* c = KARG(1); const float* w_ada = KARG(2); const float* b_ada = KARG(3); const float* lam = KARG(13);
        float* MOD = WSP(float, WS_MOD); float* LS8 = WSP(float, WS_LS8);
        LAS float* scl = (LAS float*)(lds + 98304);
        LAS float* red = (LAS float*)(lds + 98304 + 16384);
        for (int i = tid; i < 4096; i += 512) { const float v = c[i]; scl[i] = v / (1.0f + __expf(-v)); }
        __syncthreads();
        if (bid == G - 1) for (int i = tid; i < D; i += 512) LS8[i] = -8.0f * log1pf(expf(-lam[i]));
        LAS float* scr = (LAS float*)(lds + wave * 8448);
        constexpr int B_MOD = NMOD / 32, B_IN = 16 * (NIN / 256), B_GU = 16 * (NGU / 256), B_DN = (FF / 64) * (D / 256), B_OUT = 16 * (D / 256), B_RG = 2 * 4 * 4;
        for (int bi = bid; bi < B_MOD + B_IN + B_GU + B_DN + B_OUT + B_RG; bi += G) {
            int r = bi;
            if (r < B_MOD) {
                const int col = lane & 31, n = r * 32 + col, k0 = wave * 128 + (lane >> 5);
                float a0 = 0.f, a1 = 0.f, a2 = 0.f, a3 = 0.f;
#pragma unroll 16
                for (int k = 0; k < 128; k += 2) { const float w = w_ada[(size_t)(k0 + k) * NMOD + n]; a0 += scl[k0 + k] * w; a1 += scl[1024 + k0 + k] * w; a2 += scl[2048 + k0 + k] * w; a3 += scl[3072 + k0 + k] * w; }
                a0 += __shfl_xor(a0, 32); a1 += __shfl_xor(a1, 32); a2 += __shfl_xor(a2, 32); a3 += __shfl_xor(a3, 32);
                __syncthreads();
                if (lane < 32) { red[(wave * 4 + 0) * 32 + col] = a0; red[(wave * 4 + 1) * 32 + col] = a1; red[(wave * 4 + 2) * 32 + col] = a2; red[(wave * 4 + 3) * 32 + col] = a3; }
                __syncthreads();
                if (tid < 128) { const int b = tid >> 5; float s = b_ada[r * 32 + col];
#pragma unroll
                    for (int w = 0; w < 8; ++w) s += red[(w * 4 + b) * 32 + col];
                    MOD[(size_t)b * NMOD + r * 32 + col] = s; }
                continue;
            }
            r -= B_MOD;
            if (r < B_IN) { const int part = r >> 6;
                            const bool i8 = (P2_I8 == 1) || (P2_I8 == 2 && (part == 3 || part == 4 || part == 6));
                            if (i8) amax_item(KARG(5), NIN, (r & 15) * 64, ((r >> 4) * 8 + wave) * 32, WSP(unsigned, WS_CMAXIN), lane);
                            else tr_item(KARG(5), NIN, (r & 15) * 64, ((r >> 4) * 8 + wave) * 32, WSP(bf16_t, WS_WIN), D, scr, lane, 0, 0); continue; } r -= B_IN;
            if (r < B_GU) { if (P10_I8) amax_item(KARG(16), NGU, (r & 15) * 64, ((r >> 4) * 8 + wave) * 32, WSP(unsigned, WS_CMAXGU), lane);
                            else tr_item(KARG(16), NGU, (r & 15) * 64, ((r >> 4) * 8 + wave) * 32, WSP(bf16_t, WS_WGU), D, scr, lane, 1, 0); continue; } r -= B_GU;
            if (r < B_DN) { tr_item(KARG(17), D, (r % 44) * 64, ((r / 44) * 8 + wave) * 32, WSP(bf16_t, WS_WDN), FF, scr, lane, 2, 0); continue; } r -= B_DN;
            if (r < B_OUT) { tr_item(KARG(14), D, (r & 15) * 64, ((r >> 4) * 8 + wave) * 32, WSP(bf16_t, WS_WOUT), D, scr, lane, 2, 0); continue; } r -= B_OUT;
            { const int sx = r >> 4, h = (r >> 2) & 3, kt = r & 3;
              tr_item((sx ? KARG(11) : KARG(9)) + (size_t)h * 65536, 256, kt * 64, wave * 32, WSP(bf16_t, WS_WRG), 256, scr, lane, 3, h * 2 + sx); }
        }
    }
    if (gridDim.x > 65536u) grid.sync();
    GRID_BAR();
    for (int rep = 0; rep < REP1; ++rep)
    { PHASE_IDS();
      { LAS float* scr = (LAS float*)(lds + wave * 8448);
        constexpr int Q_IN = P2_I8 == 1 ? 16 * (NIN / 256) : (P2_I8 == 2 ? 16 * 12 : 0), Q_GU = P10_I8 ? 16 * (NGU / 256) : 0;
        for (int r0 = bid; r0 < Q_IN + Q_GU; r0 += G) {
            int r = r0;
            if (r < Q_IN) {
                if (P2_I8 == 1) q_item(KARG(5), NIN, (r & 15) * 64, ((r >> 4) * 8 + wave) * 32, WSP(signed char, WS_WIN), D, WSP(unsigned, WS_CMAXIN), WSP(float, WS_SBIN), scr, lane, 0);
                else { const int j = r >> 4, part = (j >> 2) == 0 ? 3 : ((j >> 2) == 1 ? 4 : 6), ng = part * 4 + (j & 3);
                       q_item(KARG(5), NIN, (r & 15) * 64, (ng * 8 + wave) * 32, WSP(signed char, WS_WIN + 8 * MiB), D, WSP(unsigned, WS_CMAXIN), WSP(float, WS_SBIN), scr, lane, 2); }
                continue; }
            r -= Q_IN;
            q_item(KARG(16), NGU, (r & 15) * 64, ((r >> 4) * 8 + wave) * 32, WSP(signed char, WS_WGU), D, WSP(unsigned, WS_CMAXGU), WSP(float, WS_SBGU), scr, lane, 1);
        }
        if (P10_I8 && bid == G - 1 && wave < 4) {
            const float* shp = WSP(float, WS_MOD) + (size_t)wave * NMOD + 3072; float mx = 0.f;
            for (int i = lane; i < D; i += 64) mx = fmaxf(mx, fabsf(shp[i]));
            mx = wave_max(mx); if (lane == 0) WSP(float, WS_SHMAX)[wave] = mx; } }
      if (P2_I8 == 1) norm_rows_i8(KARG(0), KARG(4), WSP(float, WS_MOD), 0, 1024, WSP(signed char, WS_H), WSP(float, WS_SA1), nullptr, gw, NGW, lane);
      else if (P2_I8 == 2) norm_rows_i8(KARG(0), KARG(4), WSP(float, WS_MOD), 0, 1024, (signed char*)OUTP, WSP(float, WS_SA1), WSP(bf16_t, WS_H), gw, NGW, lane);
      else norm_rows_bf16(KARG(0), KARG(4), WSP(float, WS_MOD), 0, 1024, WSP(bf16_t, WS_H), gw, NGW, lane); }
    GRID_BAR();
    for (int rep = 0; rep < REP2; ++rep)
    if (P2_I8 == 1) { pg8::GemmI8 g{WSP(signed char, WS_H), WSP(signed char, WS_WIN), M, NIN, D, D, D}; pg8::StaticOrder S; S.init(M, NIN, G, cid);
      EpiI8<Epi1> E{WSP(float, WS_SA1), WSP(float, WS_SBIN), Epi1{WSP(bf16_t, WS_SA), WSP(bf16_t, WS_P), WSP(bf16_t, WS_G2), WSP(bf16_t, WS_RX)}, 0}; pg8::gemm_phase_i8(lds, g, S, E); }
    else if (P2_I8 == 2) {
      if (CONV3_FUSED) { pg8::Gemm g{WSP(bf16_t, WS_H), WSP(bf16_t, WS_WIN), M, 4096, D, D, D, -1}; pg8::StaticOrder S; S.init(M, 4096, G, cid);
        EpiConvA E{WSP(bf16_t, WS_SA), WSP(bf16_t, WS_P), WSP(bf16_t, WS_P + 1 * MiB), KARG(6)}; pg8::gemm_phase<EpiConvA, true>(lds, g, S, E); }
      else { pg8::Gemm g{WSP(bf16_t, WS_H), WSP(bf16_t, WS_WIN), M, 4096, D, D, D, -1}; pg8::StaticOrder S; S.init(M, 4096, G, cid);
        Epi1 E{WSP(bf16_t, WS_SA), WSP(bf16_t, WS_P), WSP(bf16_t, WS_G2), WSP(bf16_t, WS_RX)}; pg8::gemm_phase(lds, g, S, E); }
      if (CONV4_FUSED) {
        { pg8::GemmI8 g{(const signed char*)OUTP, WSP(signed char, WS_WIN + 8 * MiB), M, 2048, D, D, D}; pg8::StaticOrder S; S.init(M, 2048, G, cid);
          EpiI8<Epi1> E{WSP(float, WS_SA1), WSP(float, WS_SBIN), Epi1{WSP(bf16_t, WS_SA), WSP(bf16_t, WS_P), WSP(bf16_t, WS_G2), WSP(bf16_t, WS_RX)}, 16}; pg8::gemm_phase_i8(lds, g, S, E); }
        { pg8::GemmI8 g{(const signed char*)OUTP, WSP(signed char, WS_WIN + 10 * MiB), M, 1024, D, D, D}; pg8::StaticOrder S; S.init(M, 1024, G, cid);
          EpiConvC E{WSP(float, WS_SA1), WSP(float, WS_SBIN) + 2048, WSP(bf16_t, WS_RX), WSP(bf16_t, WS_P + 2 * MiB), KARG(7), KARG(8)}; pg8::gemm_phase_i8<EpiConvC, true>(lds, g, S, E); } }
      else { pg8::GemmI8 g{(const signed char*)OUTP, WSP(signed char, WS_WIN + 8 * MiB), M, 3072, D, D, D}; pg8::StaticOrder S; S.init(M, 3072, G, cid);
        EpiI8<Epi1> E{WSP(float, WS_SA1), WSP(float, WS_SBIN), Epi1{WSP(bf16_t, WS_SA), WSP(bf16_t, WS_P), WSP(bf16_t, WS_G2), WSP(bf16_t, WS_RX)}, 16}; pg8::gemm_phase_i8(lds, g, S, E); } }
    else { pg8::Gemm g{WSP(bf16_t, WS_H), WSP(bf16_t, WS_WIN), M, NIN, D, D, D, -1}; pg8::StaticOrder S; S.init(M, NIN, G, cid);
      Epi1 E{WSP(bf16_t, WS_SA), WSP(bf16_t, WS_P), WSP(bf16_t, WS_G2), WSP(bf16_t, WS_RX)}; pg8::gemm_phase(lds, g, S, E); }
    GRID_BAR();
    if (CONV4_FUSED && P2_I8 == 2 && SCAN_FUSED && FIX_IN_P4) { }
    else if (CONV4_FUSED && P2_I8 == 2) {
        PHASE_IDS();
        const int gt = bid * 512 + tid;
        if (gt < (M / 128) * 128) {
            const int hb = gt >> 7, c8 = (gt & 127) * 8;
            if (((hb * 128) & (SEQ - 1)) != 0)
                conv_fix_item(hb, c8, true, SCAN_FUSED != 0, KARG(7), KARG(8), KARG(6), WSP(bf16_t, WS_P + 2 * MiB), WSP(bf16_t, WS_RX), WSP(bf16_t, WS_SA), WSP(bf16_t, WS_P), WSP(bf16_t, WS_P + 1 * MiB));
        }
    } else
    for (int rep = 0; rep < REP3; ++rep)
    {
        PHASE_IDS();
        const float* conv_b_w = KARG(7); const float* conv_b_bias = KARG(8); const bf16_t* RX = WSP(bf16_t, WS_RX); bf16_t* U = WSP(bf16_t, WS_H);
        const int c8 = (tid & 127) * 8, tq = tid >> 7;
        float w[4][8], bb[8];
#pragma unroll
        for (int k = 0; k < 4; ++k)
#pragma unroll
            for (int j = 0; j < 8; ++j) w[k][j] = conv_b_w[k * D + c8 + j];
#pragma unroll
        for (int j = 0; j < 8; ++j) bb[j] = conv_b_bias[c8 + j];
        for (int it = bid; it < M / 16; it += G) {
            const int t0 = it * 16 + tq * 4, tb = t0 & (SEQ - 1);
            u32x4 r[7];
#pragma unroll
            for (int i = 0; i < 7; ++i) { r[i] = (u32x4){0u, 0u, 0u, 0u}; if (tb - 3 + i >= 0) r[i] = *(const u32x4*)(RX + (size_t)(t0 - 3 + i) * D + c8); }
#pragma unroll
            for (int o = 0; o < 4; ++o) {
                float v[8];
#pragma unroll
                for (int j = 0; j < 8; ++j) v[j] = bb[j];
#pragma unroll
                for (int k = 0; k < 4; ++k) { const u32x4 q = r[o + k];
                    v[0] += w[k][0] * bf_lo(q.x); v[1] += w[k][1] * bf_hi(q.x); v[2] += w[k][2] * bf_lo(q.y); v[3] += w[k][3] * bf_hi(q.y);
                    v[4] += w[k][4] * bf_lo(q.z); v[5] += w[k][5] * bf_hi(q.z); v[6] += w[k][6] * bf_lo(q.w); v[7] += w[k][7] * bf_hi(q.w); }
                u32x4 wv; wv.x = cvt_pk_bf16(v[0], v[1]); wv.y = cvt_pk_bf16(v[2], v[3]); wv.z = cvt_pk_bf16(v[4], v[5]); wv.w = cvt_pk_bf16(v[6], v[7]);
                *(u32x4*)(U + (size_t)(t0 + o) * D + c8) = wv;
            }
        }
    }
    if (!(CONV4_FUSED && P2_I8 == 2 && SCAN_FUSED && FIX_IN_P4)) GRID_BAR();
    if (SCAN_FUSED) {
      if (FIX_IN_P4) {
        PHASE_IDS();
        pg8::StaticOrder S0; S0.init(M, 2048, G, cid); S0.chain = 1;
        if (tid < 256) {
            const int r = tid >> 6, hh = (tid >> 5) & 1, k = tid & 31; pg8::Unit u0;
            if (S0.next(r, u0)) { const int hb = 2 * u0.pm + hh, c8 = (u0.pn >> 1) * 256 + k * 8;
                if (((hb * 128) & (SEQ - 1)) != 0)
                    conv_fix_item(hb, c8, true, (c8 >> 7) == u0.pn, KARG(7), KARG(8), KARG(6), WSP(bf16_t, WS_P + 2 * MiB), WSP(bf16_t, WS_RX), WSP(bf16_t, WS_SA), WSP(bf16_t, WS_P), WSP(bf16_t, WS_P + 1 * MiB)); }
        }
        asm volatile("s_waitcnt vmcnt(0)" ::: "memory"); __syncthreads();
      }
      pg8::Gemm g{WSP(bf16_t, WS_RX), WSP(bf16_t, WS_WRG), M, 2048, 256, D, 256, 1}; pg8::StaticOrder S; S.init(M, 2048, G, cid); S.chain = 1;
      EpiRG3 E{WSP(bf16_t, WS_RX), WSP(bf16_t, WS_H), WSP(unsigned long long, WS_TOT), WSP(unsigned, WS_FLAG), KARG(10), KARG(12), WSP(float, WS_LS8), (LAS float*)(lds + LDS_XCH),
               WSP(bf16_t, WS_SA), WSP(bf16_t, WS_G2), WSP(bf16_t, WS_P), WSP(bf16_t, WS_P + 1 * MiB), KARG(6)};
      pg8::gemm_phase<EpiRG3, true>(lds, g, S, E); }
    else
    for (int rep = 0; rep < REP4; ++rep)
    { constexpr size_t WS_U = (CONV4_FUSED && P2_I8 == 2) ? WS_RX : WS_H;
      pg8::Gemm g{WSP(bf16_t, WS_U), WSP(bf16_t, WS_WRG), M, 2048, 256, D, 256, 1}; pg8::StaticOrder S; S.init(M, 2048, G, cid);
      EpiRG2 E{WSP(bf16_t, WS_U), WSP(bf16_t, WS_BX), WSP(bf16_t, WS_BX + 64 * MiB), WSP(float, WS_APROD), WSP(float, WS_HEND), KARG(10), KARG(12), WSP(float, WS_LS8), (LAS float*)(lds + LDS_XCH)};
      pg8::gemm_phase<EpiRG2, true>(lds, g, S, E); }
    GRID_BAR();
    if (SCAN_FUSED) {   } else
    if (CONV3_FUSED) {
        PHASE_IDS();
        const float* conv_a_w = KARG(6); const float* AT = WSP(float, WS_APROD); const float* HT = WSP(float, WS_HEND);
        const bf16_t* HL = WSP(bf16_t, WS_BX); const bf16_t* PC = WSP(bf16_t, WS_BX + 64 * MiB);
        const bf16_t* YA = WSP(bf16_t, WS_SA); const bf16_t* PT = WSP(bf16_t, WS_P); const bf16_t* ST = WSP(bf16_t, WS_P + 1 * MiB); const bf16_t* G2 = WSP(bf16_t, WS_G2); bf16_t* MERGED = WSP(bf16_t, WS_RX);
        const int c8 = (tid & 127) * 8, tq = tid >> 7;
        float w0[8], w1[8];
#pragma unroll
        for (int j = 0; j < 8; ++j) { w0[j] = conv_a_w[c8 + j]; w1[j] = conv_a_w[D + c8 + j]; }
        for (int it = bid; it < M / 64; it += G) {
            const int pm = it >> 2, kb = pm & 31;
            float cy[8];
#pragma unroll
            for (int j = 0; j < 8; ++j) cy[j] = 0.f;
#pragma unroll 4
            for (int k = pm - kb; k < pm; ++k) {
                const f32x4 a0 = *(const f32x4*)(AT + (size_t)k * D + c8), a1 = *(const f32x4*)(AT + (size_t)k * D + c8 + 4), h0 = *(const f32x4*)(HT + (size_t)k * D + c8), h1 = *(const f32x4*)(HT + (size_t)k * D + c8 + 4);
#pragma unroll
                for (int j = 0; j < 4; ++j) { cy[j] = a0[j] * cy[j] + h0[j]; cy[4 + j] = a1[j] * cy[4 + j] + h1[j]; }
            }
            const int t0 = it * 64 + tq * 16;
            float fx0[8], fx1[8];
#pragma unroll
            for (int j = 0; j < 8; ++j) { fx0[j] = 0.f; fx1[j] = 0.f; }
            if ((t0 & 127) == 0 && (t0 & (SEQ - 1)) != 0) {
                const int hb = t0 >> 7;
                const u32x4 s0 = *(const u32x4*)(ST + (size_t)(hb * 2 + 0) * D + c8), s1 = *(const u32x4*)(ST + (size_t)(hb * 2 + 1) * D + c8);
                const u32x4 pa = *(const u32x4*)(PT + (size_t)((hb - 1) * 2 + 0) * D + c8), pb = *(const u32x4*)(PT + (size_t)((hb - 1) * 2 + 1) * D + c8);
                const unsigned s0w[4] = {s0.x, s0.y, s0.z, s0.w}, s1w[4] = {s1.x, s1.y, s1.z, s1.w}, paw[4] = {pa.x, pa.y, pa.z, pa.w}, pbw[4] = {pb.x, pb.y, pb.z, pb.w};
#pragma unroll
                for (int q = 0; q < 4; ++q) {
                    const int j0 = 2 * q, j1 = 2 * q + 1;
                    fx0[j0] = bf_lo(s0w[q]) * (w0[j0] * bf_lo(paw[q]) + w1[j0] * bf_lo(pbw[q])); fx0[j1] = bf_hi(s0w[q]) * (w0[j1] * bf_hi(paw[q]) + w1[j1] * bf_hi(pbw[q]));
                    fx1[j0] = bf_lo(s1w[q]) * (w0[j0] * bf_lo(pbw[q]));                            fx1[j1] = bf_hi(s1w[q]) * (w0[j1] * bf_hi(pbw[q]));
                }
            }
            for (int tb = 0; tb < 16; tb += 4) {
                u32x4 qh[4], qc[4], qy[4], qg[4];
#pragma unroll
                for (int t = 0; t < 4; ++t) { const unsigned o = ((unsigned)(t0 + tb + t) * D + c8) * 2u; qh[t] = *(const u32x4*)((const char*)HL + o); qc[t] = *(const u32x4*)((const char*)PC + o); qy[t] = *(const u32x4*)((const char*)YA + o); qg[t] = *(const u32x4*)((const char*)G2 + o); }
#pragma unroll
                for (int t = 0; t < 4; ++t) {
                    const unsigned hw[4] = {qh[t].x, qh[t].y, qh[t].z, qh[t].w}, cw[4] = {qc[t].x, qc[t].y, qc[t].z, qc[t].w}, yw[4] = {qy[t].x, qy[t].y, qy[t].z, qy[t].w}, gw4[4] = {qg[t].x, qg[t].y, qg[t].z, qg[t].w};
                    unsigned ow[4];
#pragma unroll
                    for (int q = 0; q < 4; ++q) {
                        const int j0 = 2 * q, j1 = 2 * q + 1;
                        const float h0 = bf_lo(hw[q]) + bf_lo(cw[q]) * cy[j0], h1 = bf_hi(hw[q]) + bf_hi(cw[q]) * cy[j1];
                        float m0 = bf_lo(yw[q]) + h0 * bf_lo(gw4[q]), m1 = bf_hi(yw[q]) + h1 * bf_hi(gw4[q]);
                        if (tb == 0 && t == 0) { m0 += fx0[j0]; m1 += fx0[j1]; }
                        if (tb == 0 && t == 1) { m0 += fx1[j0]; m1 += fx1[j1]; }
                        ow[q] = cvt_pk_bf16(m0, m1);
                    }
                    *(u32x4*)((char*)MERGED + ((unsigned)(t0 + tb + t) * D + c8) * 2u) = (u32x4){ow[0], ow[1], ow[2], ow[3]};
                }
            }
        }
    } else
    for (int rep = 0; rep < REP7; ++rep)
    {
        PHASE_IDS();
        const float* conv_a_w = KARG(6); const float* AT = WSP(float, WS_APROD); const float* HT = WSP(float, WS_HEND);
        const bf16_t* HL = WSP(bf16_t, WS_BX); const bf16_t* PC = WSP(bf16_t, WS_BX + 64 * MiB);
        const bf16_t* PP = WSP(bf16_t, WS_P); const bf16_t* SA = WSP(bf16_t, WS_SA); const bf16_t* G2 = WSP(bf16_t, WS_G2); bf16_t* MERGED = WSP(bf16_t, WS_RX);
        const int c8 = (tid & 127) * 8, tq = tid >> 7;
        float w0[8], w1[8], w2[8];
#pragma unroll
        for (int j = 0; j < 8; ++j) { w0[j] = conv_a_w[c8 + j]; w1[j] = conv_a_w[D + c8 + j]; w2[j] = conv_a_w[2 * D + c8 + j]; }
        for (int it = bid; it < M / 64; it += G) {
            const int pm = it >> 2, kb = pm & 31;
            float cy[8];
#pragma unroll
            for (int j = 0; j < 8; ++j) cy[j] = 0.f;
#pragma unroll 4
            for (int k = pm - kb; k < pm; ++k) {
                const f32x4 a0 = *(const f32x4*)(AT + (size_t)k * D + c8), a1 = *(const f32x4*)(AT + (size_t)k * D + c8 + 4), h0 = *(const f32x4*)(HT + (size_t)k * D + c8), h1 = *(const f32x4*)(HT + (size_t)k * D + c8 + 4);
#pragma unroll
                for (int j = 0; j < 4; ++j) { cy[j] = a0[j] * cy[j] + h0[j]; cy[4 + j] = a1[j] * cy[4 + j] + h1[j]; }
            }
            const int t0 = it * 64 + tq * 16;
            float pm2[8], pm1[8];
            {
                u32x4 q2 = {0u, 0u, 0u, 0u}, q1 = {0u, 0u, 0u, 0u};
                if ((t0 & (SEQ - 1)) != 0) { q2 = *(const u32x4*)(PP + (size_t)(t0 - 2) * D + c8); q1 = *(const u32x4*)(PP + (size_t)(t0 - 1) * D + c8); }
                pm2[0] = bf_lo(q2.x); pm2[1] = bf_hi(q2.x); pm2[2] = bf_lo(q2.y); pm2[3] = bf_hi(q2.y); pm2[4] = bf_lo(q2.z); pm2[5] = bf_hi(q2.z); pm2[6] = bf_lo(q2.w); pm2[7] = bf_hi(q2.w);
                pm1[0] = bf_lo(q1.x); pm1[1] = bf_hi(q1.x); pm1[2] = bf_lo(q1.y); pm1[3] = bf_hi(q1.y); pm1[4] = bf_lo(q1.z); pm1[5] = bf_hi(q1.z); pm1[6] = bf_lo(q1.w); pm1[7] = bf_hi(q1.w);
            }
            for (int tb = 0; tb < 16; tb += 4) {
                u32x4 qh[4], qc[4], qp[4], qs[4], qg[4];
#pragma unroll
                for (int t = 0; t < 4; ++t) { const unsigned o = ((unsigned)(t0 + tb + t) * D + c8) * 2u; qh[t] = *(const u32x4*)((const char*)HL + o); qc[t] = *(const u32x4*)((const char*)PC + o); qp[t] = *(const u32x4*)((const char*)PP + o); qs[t] = *(const u32x4*)((const char*)SA + o); qg[t] = *(const u32x4*)((const char*)G2 + o); }
#pragma unroll
                for (int t = 0; t < 4; ++t) {
                    const unsigned hw[4] = {qh[t].x, qh[t].y, qh[t].z, qh[t].w}, cw[4] = {qc[t].x, qc[t].y, qc[t].z, qc[t].w}, pw[4] = {qp[t].x, qp[t].y, qp[t].z, qp[t].w},
                                   sw[4] = {qs[t].x, qs[t].y, qs[t].z, qs[t].w}, gw4[4] = {qg[t].x, qg[t].y, qg[t].z, qg[t].w};
                    unsigned ow[4];
#pragma unroll
                    for (int q = 0; q < 4; ++q) {
                        const int j0 = 2 * q, j1 = 2 * q + 1;
                        const float pc0 = bf_lo(pw[q]), pc1 = bf_hi(pw[q]);
                        const float h0 = bf_lo(hw[q]) + bf_lo(cw[q]) * cy[j0], h1 = bf_hi(hw[q]) + bf_hi(cw[q]) * cy[j1];
                        const float m0 = bf_lo(sw[q]) * (w0[j0] * pm2[j0] + w1[j0] * pm1[j0] + w2[j0] * pc0) + h0 * bf_lo(gw4[q]);
                        const float m1 = bf_hi(sw[q]) * (w0[j1] * pm2[j1] + w1[j1] * pm1[j1] + w2[j1] * pc1) + h1 * bf_hi(gw4[q]);
                        ow[q] = cvt_pk_bf16(m0, m1);
                        pm2[j0] = pm1[j0]; pm1[j0] = pc0; pm2[j1] = pm1[j1]; pm1[j1] = pc1;
                    }
                    *(u32x4*)((char*)MERGED + ((unsigned)(t0 + tb + t) * D + c8) * 2u) = (u32x4){ow[0], ow[1], ow[2], ow[3]};
                }
            }
        }
    }
    if (!SCAN_FUSED) GRID_BAR();
    for (int rep = 0; rep < REP8; ++rep)
    { pg8::Gemm g{SCAN_FUSED ? WSP(bf16_t, WS_H) : WSP(bf16_t, WS_RX), WSP(bf16_t, WS_WOUT), M, D, D, D, D, -1}; pg8::StaticOrder S; S.init(M, D, G, cid);
      EpiResNorm<0, P10_I8 != 0> E{KARG(0), WSP(bf16_t, WS_BX), WSP(float, WS_MOD) + 2048, WSP(float, WS_RSS1), WSP(unsigned, WS_CNT1), KARG(15), WSP(float, WS_MOD), SCAN_FUSED ? (bf16_t*)OUTP : WSP(bf16_t, WS_H), WSP(unsigned, WS_RMX), WSP(float, WS_SA2), WSP(float, WS_SHMAX)}; pg8::gemm_phase(lds, g, S, E); }
    GRID_BAR();
    for (int rep = 0; rep < REP10; ++rep)
    if (P10_I8) { pg8::GemmI8 g{SCAN_FUSED ? (const signed char*)OUTP : WSP(signed char, WS_H), WSP(signed char, WS_WGU), M, NGU, D, D, D}; pg8::StaticOrder S; S.init(M, NGU, G, cid);
      EpiI8<EpiGU> E{WSP(float, WS_SA2), WSP(float, WS_SBGU), EpiGU{WSP(bf16_t, WS_ACT)}, 0}; pg8::gemm_phase_i8(lds, g, S, E); }
    else { pg8::Gemm g{WSP(bf16_t, WS_H), WSP(bf16_t, WS_WGU), M, NGU, D, D, D, -1}; pg8::StaticOrder S; S.init(M, NGU, G, cid); EpiGU E{WSP(bf16_t, WS_ACT)}; pg8::gemm_phase(lds, g, S, E); }
    GRID_BAR();
    for (int rep = 0; rep < REP11; ++rep)
    { pg8::Gemm g{WSP(bf16_t, WS_ACT), WSP(bf16_t, WS_WDN), M, D, FF, FF, FF, -1}; pg8::StaticOrder S; S.init(M, D, G, cid);
      EpiResNorm<1> E{WSP(bf16_t, WS_BX), OUTP, WSP(float, WS_MOD) + 5120, WSP(float, WS_RSS2), WSP(unsigned, WS_CNT2), KARG(18), nullptr, nullptr, nullptr, nullptr, nullptr}; pg8::gemm_phase(lds, g, S, E); }
    if (pass + 1 < NPASS) GRID_BAR();
    }
}

extern "C" void kernel_launch(void* const* d_in, const int* in_sizes, int n_in, void* d_out, int out_size, void* d_ws, size_t ws_size, hipStream_t stream) {
    static int grid_blocks = 0;
    if (grid_blocks == 0) {
        if (n_in != 19 || out_size != M * D || ws_size < WS_END) { fprintf(stderr, "kernel_launch: unexpected shapes (n_in %d out %d ws %zu)\n", n_in, out_size, ws_size); grid_blocks = -1; return; }
        int dev = 0, cus = 0, per_cu = 0;
        hipGetDevice(&dev);
        hipDeviceGetAttribute(&cus, hipDeviceAttributeMultiprocessorCount, dev);
        hipFuncSetAttribute((const void*)fwd_megakernel, hipFuncAttributeMaxDynamicSharedMemorySize, LDS_BYTES);
        hipOccupancyMaxActiveBlocksPerMultiprocessor(&per_cu, (const void*)fwd_megakernel, 512, LDS_BYTES);
        if (per_cu < 1) { fprintf(stderr, "kernel_launch: occupancy query says %d blocks per CU\n", per_cu); grid_blocks = -1; return; }
        if (SCAN_FUSED && cus != 256) { fprintf(stderr, "kernel_launch: the chain-ordered scan phase is laid out for 256 CUs, this device has %d\n", cus); grid_blocks = -1; return; }
        grid_blocks = cus;
    }
    if (grid_blocks < 0) return;
    if (hipMemsetAsync((char*)d_ws + WS_BAR, 0, (WS_CTL_END - WS_BAR), stream) != hipSuccess) { fprintf(stderr, "kernel_launch: memset of the barrier words failed\n"); return; }
    Params p{};
    for (int i = 0; i < 19; ++i) p.in[i] = (const float*)d_in[i];
    p.out = (float*)d_out; p.ws = (unsigned char*)d_ws;
    void* args[] = {&p};
    hipError_t e = hipLaunchCooperativeKernel((const void*)fwd_megakernel, dim3(grid_blocks), dim3(512), args, LDS_BYTES, stream);
    if (e != hipSuccess) fprintf(stderr, "cooperative launch failed: %s (grid %d)\n", hipGetErrorString(e), grid_blocks);
}
```
